# Optimizing an MI355X kernel written in HIP

```python
import math
import jax
import jax.numpy as jnp
from jax import lax
import numpy as np

D_MODEL = 1024
BATCH = 4
SEQ = 4096
DEPTH = 4
DEC_BATCH = 128
DEC_SEQ = 1
PAST_LEN = 8192
PAGE_SIZE = 128

N_A = DEPTH // 2
N_B = DEPTH - N_A
MEM_TOKENS = 256
MEM_HEADS = 4
MEM_W = D_MODEL // 4
MEM_HD = MEM_W // MEM_HEADS
MIX_MAIN = D_MODEL - MEM_W
RET_HEADS = 6
RET_HD = MIX_MAIN // RET_HEADS
RET_CHUNK = 128
SWA_HEADS = 12
SWA_KV_HEADS = 4
SWA_HD = MIX_MAIN // SWA_HEADS
WINDOW = 128
D_FF = 4 * D_MODEL
EPS = 1e-6

kernel_name = 'yoco_retention_swa_sink_memory_decoder'

F32 = jnp.float32


def rmsnorm(x, g):
    xf = x.astype(F32)
    y = xf * lax.rsqrt(jnp.mean(xf * xf, axis=-1, keepdims=True) + EPS)
    return (y * g.astype(F32)).astype(x.dtype)


def sq_relu_mlp(x, g, w_up, w_down):
    h = rmsnorm(x, g) @ w_up
    return jnp.square(jax.nn.relu(h)) @ w_down


def head_groupnorm(o):
    mu = jnp.mean(o, axis=-1, keepdims=True)
    var = jnp.mean(jnp.square(o - mu), axis=-1, keepdims=True)
    return (o - mu) * lax.rsqrt(var + EPS)


def retention_log_decay():
    return jnp.asarray(np.log1p(-(2.0 ** (-5.0 - np.arange(RET_HEADS)))), F32)


def alibi_slopes(n):
    def pow2(m):
        start = 2.0 ** (-8.0 / m)
        return [start ** (i + 1) for i in range(m)]
    if math.log2(n).is_integer():
        s = pow2(n)
    else:
        c = 2 ** int(math.floor(math.log2(n)))
        s = pow2(c) + pow2(2 * c)[0::2][: n - c]
    return np.asarray(s, np.float32)


def retention(q, k, v, s0):
    b, L, h, dk = q.shape
    dv = v.shape[-1]
    c = math.gcd(L, RET_CHUNK)
    n = L // c
    log_g = retention_log_decay()
    qf = q.astype(F32).reshape(b, n, c, h, dk)
    kf = (k.astype(F32) * dk ** -0.5).reshape(b, n, c, h, dk)
    vf = v.astype(F32).reshape(b, n, c, h, dv)
    idx = jnp.arange(c, dtype=F32)
    diff = idx[:, None] - idx[None, :]
    decay = jnp.where(diff >= 0, jnp.exp(jnp.maximum(diff, 0.0)[None] * log_g[:, None, None]), 0.0)
    scores = jnp.einsum('bnqhd,bnkhd->bnhqk', qf, kf) * decay
    inner = jnp.einsum('bnhqk,bnkhe->bnqhe', scores, vf)
    w_k = jnp.exp((c - 1.0 - idx)[:, None] * log_g[None, :])
    kv_chunk = jnp.einsum('bnkhd,bnkhe->bnhde', kf * w_k[:, :, None], vf)
    g_c = jnp.exp(c * log_g)[:, None, None]

    def step(s, kvc):
        return g_c * s + kvc, s

    s_last, s_prev = lax.scan(step, s0.astype(F32), jnp.moveaxis(kv_chunk, 1, 0))
    s_prev = jnp.moveaxis(s_prev, 0, 1)
    w_q = jnp.exp((idx + 1.0)[:, None] * log_g[None, :])
    cross = jnp.einsum('bnqhd,bnhde->bnqhe', qf * w_q[:, :, None], s_prev)
    return (inner + cross).reshape(b, L, h, dv), s_last


def memory_kv(mem, g, w):
    b, m, _ = mem.shape
    k, v = jnp.split(rmsnorm(mem, g) @ w, 2, axis=-1)
    return k.reshape(b, m, MEM_HEADS, MEM_HD), v.reshape(b, m, MEM_HEADS, MEM_HD)


def memory_attention(q, mk, mv):
    s = jnp.einsum('blhd,bmhd->bhlm', q.astype(F32), mk.astype(F32)) * MEM_HD ** -0.5
    p = jax.nn.softmax(s, axis=-1)
    return jnp.einsum('bhlm,bmhd->blhd', p, mv.astype(F32)).astype(q.dtype)


def sink_softmax(s, sink):
    m = jnp.maximum(jnp.max(s, axis=-1, keepdims=True), sink)
    e = jnp.exp(s - m)
    return e / (jnp.sum(e, axis=-1, keepdims=True) + jnp.exp(sink - m))


def windowed_sink_attention(q, k, v, qpos, kpos, sinks):
    g, r, hd = q.shape[3:]
    slopes = jnp.asarray(alibi_slopes(g * r)).reshape(g, r)
    dist = qpos[:, :, None] - kpos[:, None, :]
    valid = (kpos[:, None, :] >= 0) & (dist >= 0) & (dist <= WINDOW)
    s = jnp.einsum('bnqgrd,bnkgd->bngrqk', q.astype(F32), k.astype(F32)) * hd ** -0.5
    s = s - slopes[None, None, :, :, None, None] * dist.astype(F32)[None, :, None, None]
    s = jnp.where(valid[None, :, None, None], s, -jnp.inf)
    sink = sinks.astype(F32).reshape(g, r)[None, None, :, :, None, None]
    p = sink_softmax(s, sink)
    return jnp.einsum('bngrqk,bnkgd->bnqgrd', p, v.astype(F32)).astype(q.dtype)


def window_attention_prompt(q, k, v, sinks):
    b, s_len, hq, hd = q.shape
    hkv = k.shape[2]
    nb = s_len // WINDOW
    qb = q.reshape(b, nb, WINDOW, hkv, hq // hkv, hd)
    kb = k.reshape(b, nb, WINDOW, hkv, hd)
    vb = v.reshape(b, nb, WINDOW, hkv, hd)
    shift = lambda t: jnp.concatenate([jnp.zeros_like(t[:, :1]), t[:, :-1]], axis=1)
    kk = jnp.concatenate([shift(kb), kb], axis=2)
    vv = jnp.concatenate([shift(vb), vb], axis=2)
    start = jnp.arange(nb)[:, None] * WINDOW
    qpos = start + jnp.arange(WINDOW)[None, :]
    kpos = start - WINDOW + jnp.arange(2 * WINDOW)[None, :]
    o = windowed_sink_attention(qb, kk, vv, qpos, kpos, sinks)
    return o.reshape(b, s_len, hq, hd)


def window_attention_decode(q, k_ctx, v_ctx, sinks):
    b, L, hq, hd = q.shape
    hkv = k_ctx.shape[2]
    qpos = (PAST_LEN + jnp.arange(L))[None, :]
    kpos = (PAST_LEN - WINDOW + jnp.arange(WINDOW + L))[None, :]
    o = windowed_sink_attention(q.reshape(b, 1, L, hkv, hq // hkv, hd), k_ctx[:, None], v_ctx[:, None], qpos, kpos, sinks)
    return o.reshape(b, L, hq, hd)


def retention_layer(x, mem_k, mem_v, s0, g_mix, w_in, w_out, g_mlp, w_up, w_down):
    b, L, _ = x.shape
    proj = rmsnorm(x, g_mix) @ w_in
    q, k, v, gate, q_mem = jnp.split(proj, [MIX_MAIN, 2 * MIX_MAIN, 3 * MIX_MAIN, 4 * MIX_MAIN], axis=-1)
    hs = lambda t: t.reshape(b, L, RET_HEADS, RET_HD)
    o_ret, s_new = retention(hs(q), hs(k), hs(v), s0)
    o_ret = (jax.nn.silu(gate.astype(F32)) * head_groupnorm(o_ret).reshape(b, L, MIX_MAIN)).astype(x.dtype)
    o_mem = memory_attention(q_mem.reshape(b, L, MEM_HEADS, MEM_HD), mem_k, mem_v).reshape(b, L, MEM_W)
    x = x + jnp.concatenate([o_ret, o_mem], axis=-1) @ w_out
    return x + sq_relu_mlp(x, g_mlp, w_up, w_down), s_new


def window_layer(x, k_ctx, v_ctx, decode, mem_k, mem_v, sinks, g_mix, w_in, w_out, g_mlp, w_up, w_down):
    b, L, _ = x.shape
    proj = rmsnorm(x, g_mix) @ w_in
    q, q_mem = jnp.split(proj, [MIX_MAIN], axis=-1)
    q = q.reshape(b, L, SWA_HEADS, SWA_HD)
    attn = window_attention_decode if decode else window_attention_prompt
    o_swa = attn(q, k_ctx, v_ctx, sinks).reshape(b, L, MIX_MAIN)
    o_mem = memory_attention(q_mem.reshape(b, L, MEM_HEADS, MEM_HD), mem_k, mem_v).reshape(b, L, MEM_W)
    x = x + jnp.concatenate([o_swa, o_mem], axis=-1) @ w_out
    return x + sq_relu_mlp(x, g_mlp, w_up, w_down)


def trunk(x, mem_k, mem_v, ret_s0, buf_k, buf_v, norm_mix, w_in_a, w_out_a, w_in_b, w_out_b,
          attn_sinks, norm_kv, w_kv, norm_mlp, w_up, w_down, norm_final):
    decode = buf_k is not None
    b, L, _ = x.shape
    ret_states = []
    k_ctx = v_ctx = None
    for l in range(DEPTH):
        if l < N_A:
            x, s = retention_layer(x, mem_k[l], mem_v[l], ret_s0[l], norm_mix[l], w_in_a[l], w_out_a[l],
                                   norm_mlp[l], w_up[l], w_down[l])
            ret_states.append(s)
            continue
        j = l - N_A
        if j == 0:
            k_new, v_new = jnp.split(rmsnorm(x, norm_kv) @ w_kv, 2, axis=-1)
            k_new = k_new.reshape(b, L, SWA_KV_HEADS, SWA_HD)
            v_new = v_new.reshape(b, L, SWA_KV_HEADS, SWA_HD)
            if decode:
                k_ctx = jnp.concatenate([buf_k.astype(x.dtype), k_new], axis=1)
                v_ctx = jnp.concatenate([buf_v.astype(x.dtype), v_new], axis=1)
            else:
                k_ctx, v_ctx = k_new, v_new
        x = window_layer(x, k_ctx, v_ctx, decode, mem_k[l], mem_v[l], attn_sinks[j], norm_mix[l],
                         w_in_b[j], w_out_b[j], norm_mlp[l], w_up[l], w_down[l])
    y = rmsnorm(x, norm_final)
    return y, jnp.stack(ret_states).astype(ret_s0.dtype), k_ctx[:, -WINDOW:], v_ctx[:, -WINDOW:]


def setup_inputs(seed: int = 0) -> dict:
    key = jax.random.key(seed)
    ks = jax.random.split(key, 24)
    nrm = lambda k, shape, s: s * jax.random.normal(k, shape, jnp.float32)
    gain = lambda k, shape: 1.0 + 0.02 * jax.random.normal(k, shape, jnp.float32)
    return {
        'x_prompt': nrm(ks[0], (BATCH, SEQ, D_MODEL), 1.0),
        'x_sample': nrm(ks[1], (DEC_BATCH, DEC_SEQ, D_MODEL), 1.0),
        'cache_mem_k': nrm(ks[2], (DEPTH, DEC_BATCH, MEM_TOKENS, MEM_HEADS, MEM_HD), 1.0),
        'cache_mem_v': nrm(ks[3], (DEPTH, DEC_BATCH, MEM_TOKENS, MEM_HEADS, MEM_HD), 1.0),
        'state_ret': nrm(ks[4], (N_A, DEC_BATCH, RET_HEADS, RET_HD, RET_HD), 0.3),
        'cache_swa_k': nrm(ks[5], (DEC_BATCH, WINDOW, SWA_KV_HEADS, SWA_HD), 1.0),
        'cache_swa_v': nrm(ks[6], (DEC_BATCH, WINDOW, SWA_KV_HEADS, SWA_HD), 1.0),
        'mem_prompt': nrm(ks[7], (BATCH, MEM_TOKENS, D_MODEL), 1.0),
        'norm_mix': gain(ks[8], (DEPTH, D_MODEL)),
        'w_in_a': nrm(ks[9], (N_A, D_MODEL, 4 * MIX_MAIN + MEM_W), D_MODEL ** -0.5),
        'w_out_a': nrm(ks[10], (N_A, MIX_MAIN + MEM_W, D_MODEL), (MIX_MAIN + MEM_W) ** -0.5),
        'w_in_b': nrm(ks[11], (N_B, D_MODEL, MIX_MAIN + MEM_W), D_MODEL ** -0.5),
        'w_out_b': nrm(ks[12], (N_B, MIX_MAIN + MEM_W, D_MODEL), (MIX_MAIN + MEM_W) ** -0.5),
        'attn_sinks': nrm(ks[13], (N_B, SWA_HEADS), 1.0),
        'norm_mem': gain(ks[14], (DEPTH, D_MODEL)),
        'w_mem_kv': nrm(ks[15], (DEPTH, D_MODEL, 2 * MEM_W), D_MODEL ** -0.5),
        'norm_kv': gain(ks[16], (D_MODEL,)),
        'w_kv': nrm(ks[17], (D_MODEL, 2 * SWA_KV_HEADS * SWA_HD), D_MODEL ** -0.5),
        'norm_mlp': gain(ks[18], (DEPTH, D_MODEL)),
        'w_up': nrm(ks[19], (DEPTH, D_MODEL, D_FF), D_MODEL ** -0.5),
        'w_down': nrm(ks[20], (DEPTH, D_FF, D_MODEL), D_FF ** -0.5),
        'norm_final': gain(ks[21], (D_MODEL,)),
    }


def reference(x_prompt, x_sample, cache_mem_k, cache_mem_v, state_ret, cache_swa_k, cache_swa_v, mem_prompt,
              norm_mix, w_in_a, w_out_a, w_in_b, w_out_b, attn_sinks, norm_mem, w_mem_kv, norm_kv, w_kv,
              norm_mlp, w_up, w_down, norm_final):
    mem_pairs = [memory_kv(mem_prompt, norm_mem[l], w_mem_kv[l]) for l in range(DEPTH)]
    mem_k_prompt = jnp.stack([p[0] for p in mem_pairs])
    mem_v_prompt = jnp.stack([p[1] for p in mem_pairs])
    ret0 = jnp.zeros((N_A, x_prompt.shape[0], RET_HEADS, RET_HD, RET_HD), state_ret.dtype)
    y_prompt, ret_prompt, swa_k_prompt, swa_v_prompt = trunk(
        x_prompt, mem_k_prompt, mem_v_prompt, ret0, None, None,
        norm_mix, w_in_a, w_out_a, w_in_b, w_out_b, attn_sinks, norm_kv, w_kv, norm_mlp, w_up, w_down, norm_final)
    y_sample, ret_sample, swa_k_sample, swa_v_sample = trunk(
        x_sample, cache_mem_k, cache_mem_v, state_ret, cache_swa_k, cache_swa_v,
        norm_mix, w_in_a, w_out_a, w_in_b, w_out_b, attn_sinks, norm_kv, w_kv, norm_mlp, w_up, w_down, norm_final)
    return (y_prompt, y_sample, ret_prompt, ret_sample, swa_k_prompt, swa_v_prompt, swa_k_sample, swa_v_sample,
            mem_k_prompt.astype(cache_mem_k.dtype), mem_v_prompt.astype(cache_mem_v.dtype))
```

```cpp
#include <hip/hip_runtime.h>
#include <hip/hip_cooperative_groups.h>
#include <cstdio>
#include <cstring>
namespace cg = cooperative_groups;
namespace pg8 {
#define PG8_LAS __attribute__((address_space(3)))
typedef unsigned short bf16_t;
typedef short bf16x8 __attribute__((ext_vector_type(8)));
typedef float f32x4 __attribute__((ext_vector_type(4)));
typedef unsigned u32x4 __attribute__((ext_vector_type(4)));
constexpr int BM = 256, BK = 64, HALF = 128, HTB = HALF * BK * 2  , STAGE_BYTES = 8 * HTB, NXCD = 8, WGM = 8;

__host__ __device__ __forceinline__ int lds_byte(int r, int c) { const int st = (r >> 4) * 2 + (c >> 5), rr = r & 15, cc = c & 31, ob = rr * 64 + cc * 2; return st * 1024 + (ob ^ (((ob >> 9) & 1) << 5)); }
__host__ __device__ __forceinline__ void stage_rc(int b, int& R, int& C) { const int st = b / 1024, sb = b % 1024, swz = sb ^ (((sb >> 9) & 1) << 5); R = (st >> 1) * 16 + swz / 64; C = (st & 1) * 32 + (swz % 64) / 2; }
__host__ __device__ __forceinline__ int perm32(int rho) { const int n = rho >> 4, i = rho & 15; return 8 * (i >> 2) + 4 * n + (i & 3); }

struct Unit { int pm, pn; };
struct Gemm { const bf16_t* A; const bf16_t* Bt; int M, N, K; };

struct StaticOrder {
    int nM, nN, nwg, G, c;
    __host__ __device__ void init(int M, int N, int G_, int c_) { nM = M / BM; nN = N / BM; nwg = nM * nN; G = G_; c = c_; }
    __host__ __device__ bool next(int i, Unit& u) const {
        const long L = (long)i * G + c; if (L >= nwg) return false;
        int wgid = (int)L; { const int q = nwg / NXCD, r = nwg % NXCD, xcd = wgid % NXCD, off = wgid / NXCD; wgid = (xcd < r ? xcd * (q + 1) : r * (q + 1) + (xcd - r) * q) + off; }
        const int nig = WGM * nN, gid = wgid / nig, fm = gid * WGM, gsz = (nM - fm) < WGM ? (nM - fm) : WGM;
        u.pm = fm + ((wgid % nig) % gsz); u.pn = (wgid % nig) / gsz; return true;
    }
    __device__ __forceinline__ void a_ready(const Unit&) const {}
    __device__ __forceinline__ void done(const Unit&) const {}
};
template <class Epi, class Sched, bool STAMP = false>
__device__ __forceinline__ void gemm_phase(PG8_LAS unsigned char* lds, const Gemm g, const Sched& S, const Epi& E, unsigned long long* stamps) {
    int tid_ = threadIdx.x; asm volatile("" : "+v"(tid_)); const int tid = tid_, wid = __builtin_amdgcn_readfirstlane(tid >> 6), lane = tid & 63, wr = wid >> 2, wc = wid & 3, fr = lane & 15, fq = lane >> 4;
    const int K = g.K, nt = K / BK;
    int ts_lo = 0, ts_hi = 0, nts = 0; const unsigned long long rt_entry = STAMP ? (unsigned long long)wall_clock64() : 0ull;
#define PG8_STAMP() do { if (STAMP && wid == 0 && nts < 64) { const unsigned long long _c = (unsigned long long)clock64(); \
        ts_lo = (lane == nts) ? (int)(unsigned)_c : ts_lo; ts_hi = (lane == nts) ? (int)(unsigned)(_c >> 32) : ts_hi; ++nts; } } while (0)
    PG8_STAMP();
    unsigned voffA[2], voffB[2];
#pragma unroll
    for (int i = 0; i < 2; ++i) { int R, C; stage_rc(tid * 16 + i * 8192, R, C); const int Rb = Epi::PERM ? ((R & ~31) + perm32(R & 31)) : R;
        voffA[i] = (unsigned)(R * K + C) * 2u; voffB[i] = (unsigned)(Rb * K + C) * 2u; }
    const size_t kstep = (size_t)(BK * 2);
    const size_t hstep = (size_t)HALF * K * 2;
    const size_t tstep = 2 * hstep;
    const unsigned ldsw = (unsigned)wid * 1024u;
    const int aoff = lds_byte(wr * 64 + fr, fq * 8), boff = lds_byte(wc * 32 + fr, fq * 8);
#define PG8_SA(b, h) (((b) * 2 + (h)) * HTB)
#define PG8_SB(b, h) ((4 + (b) * 2 + (h)) * HTB)
#define PG8_STAGE(bufoff, gbase, voff) do { _Pragma("unroll") for (int _i = 0; _i < 2; ++_i) \
        __builtin_amdgcn_global_load_lds((const unsigned*)((const char*)(gbase) + (voff)[_i]), (PG8_LAS unsigned*)(lds + (bufoff) + ldsw + _i * 8192), 16, 0, 0); } while (0)
#define PG8_LDA(dst, b, h) do { _Pragma("unroll") for (int m = 0; m < 4; ++m) _Pragma("unroll") for (int k = 0; k < 2; ++k) dst[m][k] = *(const PG8_LAS bf16x8*)(lds + PG8_SA(b, h) + aoff + m * 2048 + k * 1024); } while (0)
#define PG8_LDB(dst, b, h) do { _Pragma("unroll") for (int n = 0; n < 2; ++n) _Pragma("unroll") for (int k = 0; k < 2; ++k) dst[n][k] = *(const PG8_LAS bf16x8*)(lds + PG8_SB(b, h) + boff + n * 2048 + k * 1024); } while (0)
#define PG8_MMA(ai, bj, At, Bt) do { __builtin_amdgcn_s_setprio(1); _Pragma("unroll") for (int m = 0; m < 4; ++m) _Pragma("unroll") for (int n = 0; n < 2; ++n) _Pragma("unroll") for (int k = 0; k < 2; ++k) \
        acc[ai][bj][m][n] = __builtin_amdgcn_mfma_f32_16x16x32_bf16(Bt[n][k], At[m][k], acc[ai][bj][m][n], 0, 0, 0); __builtin_amdgcn_s_setprio(0); } while (0)
#define PG8_WAIT_V(n) asm volatile("s_waitcnt vmcnt(" #n ")" ::: "memory")
#define PG8_WAIT_L(n) asm volatile("s_waitcnt lgkmcnt(" #n ")" ::: "memory")
#define PG8_BAR __builtin_amdgcn_s_barrier()
#define PG8_SCHED __builtin_amdgcn_sched_barrier(0)
    Unit cur, nxt; int ui = 0;
    if (!S.next(0, cur)) return;
    f32x4 acc[2][2][4][2];
#pragma unroll
    for (int a = 0; a < 2; ++a)
#pragma unroll
        for (int b = 0; b < 2; ++b)
#pragma unroll
            for (int m = 0; m < 4; ++m)
#pragma unroll
                for (int n = 0; n < 2; ++n) acc[a][b][m][n] = (f32x4){0.f, 0.f, 0.f, 0.f};
    bf16x8 At[4][2], B0[2][2], B1[2][2];
    const char* cA = (const char*)g.A + (size_t)cur.pm * tstep; const char* cB = (const char*)g.Bt + (size_t)cur.pn * tstep;
    S.a_ready(cur);
    PG8_STAGE(PG8_SB(0, 0), cB, voffB); PG8_STAGE(PG8_SA(0, 0), cA, voffA); PG8_STAGE(PG8_SB(0, 1), cB + hstep, voffB); PG8_STAGE(PG8_SA(0, 1), cA + hstep, voffA);
    if (wr == 1) PG8_BAR;
    PG8_WAIT_V(4); PG8_BAR;
    PG8_STAGE(PG8_SB(1, 0), cB + kstep, voffB); PG8_STAGE(PG8_SA(1, 0), cA + kstep, voffA); PG8_STAGE(PG8_SB(1, 1), cB + hstep + kstep, voffB);
    PG8_WAIT_V(6); PG8_BAR;
    PG8_STAMP();
    for (;;) {
        const bool has_next = S.next(ui + 1, nxt);
        const char* nA = has_next ? (const char*)g.A + (size_t)nxt.pm * tstep : cA; const char* nB = has_next ? (const char*)g.Bt + (size_t)nxt.pn * tstep : cB;
        for (int t = 0; t < nt; t += 2) {
            const bool last = (t == nt - 2);
            const char* a1 = cA + (size_t)(t + 1) * kstep;
            const char* a2 = last ? nA : cA + (size_t)(t + 2) * kstep; const char* b2 = last ? nB : cB + (size_t)(t + 2) * kstep;
            const char* a3 = a2 + kstep; const char* b3 = b2 + kstep;
            if (last && has_next) S.a_ready(nxt);
            PG8_LDB(B0, 0, 0); PG8_SCHED; PG8_LDA(At, 0, 0); PG8_STAGE(PG8_SA(1, 1), a1 + hstep, voffA);
            PG8_WAIT_L(8); PG8_BAR; PG8_WAIT_L(0); PG8_MMA(0, 0, At, B0); PG8_BAR; PG8_SCHED;
            PG8_LDB(B1, 0, 1); PG8_STAGE(PG8_SB(0, 0), b2, voffB);
            PG8_BAR; PG8_WAIT_L(0); PG8_MMA(0, 1, At, B1); PG8_BAR;
            PG8_LDA(At, 0, 1); PG8_STAGE(PG8_SA(0, 0), a2, voffA);
            PG8_BAR; PG8_WAIT_L(0); PG8_MMA(1, 0, At, B0); PG8_BAR; PG8_SCHED;
            PG8_STAGE(PG8_SB(0, 1), b2 + hstep, voffB);
            PG8_WAIT_V(6); PG8_BAR; PG8_MMA(1, 1, At, B1); PG8_BAR;
            PG8_LDB(B0, 1, 0); PG8_SCHED; PG8_LDA(At, 1, 0); PG8_STAGE(PG8_SA(0, 1), a2 + hstep, voffA);
            PG8_WAIT_L(8); PG8_BAR; PG8_WAIT_L(0); PG8_MMA(0, 0, At, B0); PG8_BAR; PG8_SCHED;
            PG8_LDB(B1, 1, 1); PG8_STAGE(PG8_SB(1, 0), b3, voffB);
            PG8_BAR; PG8_WAIT_L(0); PG8_MMA(0, 1, At, B1); PG8_BAR;
            PG8_LDA(At, 1, 1); PG8_STAGE(PG8_SA(1, 0), a3, voffA);
            PG8_BAR; PG8_WAIT_L(0); PG8_MMA(1, 0, At, B0); PG8_BAR; PG8_SCHED;
            PG8_STAGE(PG8_SB(1, 1), b3 + hstep, voffB);
            PG8_WAIT_V(6); PG8_BAR; PG8_MMA(1, 1, At, B1); PG8_BAR;
        }
        PG8_STAMP();
        if constexpr (!Epi::AFTER_DRAIN) { E(acc, cur, wr, wc, fr, fq); S.done(cur); }
        PG8_STAMP();
        if (!has_next) break;
#pragma unroll
        for (int a = 0; a < 2; ++a)
#pragma unroll
            for (int b = 0; b < 2; ++b)
#pragma unroll
                for (int m = 0; m < 4; ++m)
#pragma unroll
                    for (int n = 0; n < 2; ++n) acc[a][b][m][n] = (f32x4){0.f, 0.f, 0.f, 0.f};
        cur = nxt; cA = nA; cB = nB; ++ui;
    }
    PG8_WAIT_V(0);
    if (wr == 0) PG8_BAR;
    PG8_BAR;
    if constexpr (Epi::AFTER_DRAIN) { E.fused(acc, cur, wr, wc, fr, fq, lds, wid, lane); S.done(cur); }
    PG8_STAMP();
    if (STAMP && wid == 0) { stamps[lane] = lane < nts ? (((unsigned long long)(unsigned)ts_hi << 32) | (unsigned)ts_lo) : 0ull;
        if (lane == 62) stamps[62] = rt_entry; if (lane == 63) stamps[63] = (unsigned long long)wall_clock64(); }
#undef PG8_STAMP
#undef PG8_SA
#undef PG8_SB
#undef PG8_STAGE
#undef PG8_LDA
#undef PG8_LDB
#undef PG8_MMA
#undef PG8_WAIT_V
#undef PG8_WAIT_L
#undef PG8_BAR
#undef PG8_SCHED
}
}

#define LAS __attribute__((address_space(3)))
typedef unsigned short bf16_t;
typedef short bf16x8 __attribute__((ext_vector_type(8)));
typedef float f32x4 __attribute__((ext_vector_type(4)));
typedef unsigned u32x4 __attribute__((ext_vector_type(4)));
typedef unsigned u32x2 __attribute__((ext_vector_type(2)));

constexpr int DM = 1024, NPR = 16384, NSM = 128, MR = 16512, MP = 16640;
constexpr float EPSN = 1e-6f;
constexpr int LDS_BYTES = 159744;
constexpr int NPHASE = 26;

constexpr size_t OFF_YP = 0, OFF_YS = 16777216, OFF_RP = 16908288, OFF_RS = 17694720, OFF_KP = 42860544, OFF_VP = 42991616,
                 OFF_KS = 43122688, OFF_VS = 47316992, OFF_MK = 51511296, OFF_MV = 52559872;
constexpr size_t WS_WINA = 0;
constexpr size_t WS_WOUT = WS_WINA + 2ull * 3328 * 1024 * 2;
constexpr size_t WS_WINB0 = WS_WOUT + 4ull * 1024 * 1024 * 2;
constexpr size_t WS_WINB1 = WS_WINB0 + 1536ull * 1024 * 2;
constexpr size_t WS_WMEM = WS_WINB1 + 1024ull * 1024 * 2;
constexpr size_t WS_WUP = WS_WMEM + 2048ull * 1024 * 2;
constexpr size_t WS_WDOWN = WS_WUP + 4ull * 4096 * 1024 * 2;
constexpr size_t WS_X = WS_WDOWN + 4ull * 4096 * 1024 * 2;
constexpr size_t WS_XB = WS_X + (size_t)MP * 1024 * 4;
constexpr size_t WS_PROJ = WS_XB + (size_t)MP * 1024 * 2;
constexpr size_t WS_O = WS_PROJ + (size_t)MP * 4096 * 2;
constexpr size_t WS_KVS = WS_O + (size_t)MP * 1024 * 2;
constexpr size_t WS_KVC = WS_KVS + (size_t)MP * 512 * 2;
constexpr size_t WS_MEMB = WS_KVC + 768ull * 16384 * 4;
constexpr size_t WS_SS = WS_MEMB + 1024ull * 1024 * 2;
constexpr size_t WS_RSM = WS_SS + 9ull * MP * 4;
constexpr size_t WS_MKV = WS_RSM + 4096;
constexpr size_t WS_BAR = WS_MKV + 1024ull * 2048 * 2;
constexpr size_t WS_END = WS_BAR + 16384;

struct Job { const float* src; const float* g; bf16_t* dst; int K, N, tstart, pad; };
struct Params {
    const float* in[22];
    float* out;
    unsigned char* ws;
    Job jobs[21];
    int njobs, ntiles, ph_lo, ph_hi;
};


__device__ __forceinline__ int ltid() { int t = threadIdx.x; asm volatile("" : "+v"(t)); return t; }
__device__ __forceinline__ int lbid() { int t = blockIdx.x; asm volatile("" : "+s"(t)); return t; }
__device__ __forceinline__ int lz() { int t = 0; asm volatile("" : "+s"(t)); return t; }
typedef float f32x2_ __attribute__((ext_vector_type(2)));
typedef __bf16 bf16x2_ __attribute__((ext_vector_type(2)));
__device__ __forceinline__ unsigned cvt2(float lo, float hi) { f32x2_ v = {lo, hi}; bf16x2_ b = __builtin_convertvector(v, bf16x2_); return __builtin_bit_cast(unsigned, b); }
__device__ __forceinline__ bf16_t f2bf(float f) { return (bf16_t)(cvt2(f, 0.f) & 0xffffu); }
__device__ __forceinline__ float bf2f(unsigned b) { return __uint_as_float(b << 16); }
__device__ __forceinline__ float bflo(unsigned w) { return __uint_as_float(w << 16); }
__device__ __forceinline__ float bfhi(unsigned w) { return __uint_as_float(w & 0xffff0000u); }
__device__ __forceinline__ bf16x8 ldfrag(const LAS bf16_t* base, int row, int stride, int k) { return *(const LAS bf16x8*)(base + row * stride + k); }
__device__ __forceinline__ f32x4 mfma16(bf16x8 a, bf16x8 b, f32x4 c) { return __builtin_amdgcn_mfma_f32_16x16x32_bf16(a, b, c, 0, 0, 0); }
__device__ __forceinline__ float wave_sum(float v) { for (int o = 32; o >= 1; o >>= 1) v += __shfl_xor(v, o); return v; }
__device__ __forceinline__ float wave_max(float v) { for (int o = 32; o >= 1; o >>= 1) v = fmaxf(v, __shfl_xor(v, o)); return v; }
__device__ __forceinline__ float log_gamma(int h) { return log1pf(-exp2f(-5.0f - (float)h)); }
__device__ __forceinline__ float alibi_slope(int hq) { return hq < 8 ? exp2f(-(float)(hq + 1)) : exp2f(-0.5f - (float)(hq - 8)); }

template <int ACT, int KV> struct EpiProj {
    static constexpr bool PERM = true, AFTER_DRAIN = false;
    bf16_t* O; int ldc; const float* ss; bf16_t* O2; float* outp;
    __device__ __forceinline__ void operator()(const f32x4 (&acc)[2][2][4][2], const pg8::Unit& u, int wr, int wc, int fr, int fq) const {
        const int row0 = u.pm * 256 + wr * 64 + fr; int colt = u.pn * 256; bf16_t* base = O; int ld = ldc; bool kvt = false;
        if (KV && colt >= 1024) { kvt = true; colt -= 1024; base = O2; ld = 512; }
        const int col0 = colt + wc * 32 + 8 * fq;
#pragma unroll
        for (int ai = 0; ai < 2; ++ai)
#pragma unroll
            for (int m = 0; m < 4; ++m) {
                const int row = row0 + ai * 128 + m * 16;
                const float rs = 1.0f / sqrtf(ss[row] * (1.0f / 1024.0f) + EPSN);
                bf16_t* rowp = base + (size_t)row * ld + col0;
                float* fo = nullptr;
                if (KV && kvt) {
                    if (row < NPR) { const int pos = row & 4095; if (pos >= 3968) fo = outp + OFF_KP + ((size_t)((row >> 12) * 128 + (pos - 3968))) * 256; }
                    else if (row < MR) fo = outp + OFF_KS + ((size_t)((row - NPR) * 128 + 127)) * 256;
                }
#pragma unroll
                for (int bj = 0; bj < 2; ++bj) {
                    f32x4 v0 = acc[ai][bj][m][0] * rs, v1 = acc[ai][bj][m][1] * rs;
                    if (ACT == 1) {
#pragma unroll
                        for (int j = 0; j < 4; ++j) { float a = fmaxf(v0[j], 0.f), b = fmaxf(v1[j], 0.f); v0[j] = a * a; v1[j] = b * b; }
                    }
                    u32x4 w; w.x = cvt2(v0[0], v0[1]); w.y = cvt2(v0[2], v0[3]); w.z = cvt2(v1[0], v1[1]); w.w = cvt2(v1[2], v1[3]);
                    *(u32x4*)(rowp + bj * 128) = w;
                    if (KV && fo) {
                        const int c = col0 + bj * 128;
                        float* f = fo + (c >= 256 ? (c - 256) + (row < NPR ? (OFF_VP - OFF_KP) : (OFF_VS - OFF_KS)) : c);
                        *(f32x4*)f = v0; *(f32x4*)(f + 4) = v1;
                    }
                }
            }
    }
};
struct EpiResid {
    static constexpr bool PERM = false, AFTER_DRAIN = false;
    float* X; bf16_t* Xb; float* ss;
    __device__ __forceinline__ void operator()(const f32x4 (&acc)[2][2][4][2], const pg8::Unit& u, int wr, int wc, int fr, int fq) const {
        const int row0 = u.pm * 256 + wr * 64 + fr, col0 = u.pn * 256 + wc * 32 + 4 * fq;
#pragma unroll
        for (int ai = 0; ai < 2; ++ai)
#pragma unroll
            for (int m = 0; m < 4; ++m) {
                const int row = row0 + ai * 128 + m * 16; const size_t off = (size_t)row * 1024 + col0; float s = 0.f;
#pragma unroll
                for (int bj = 0; bj < 2; ++bj)
#pragma unroll
                    for (int n = 0; n < 2; ++n) {
                        f32x4 x = *(const f32x4*)(X + off + bj * 128 + n * 16) + acc[ai][bj][m][n];
                        *(f32x4*)(X + off + bj * 128 + n * 16) = x;
                        u32x2 w; w.x = cvt2(x[0], x[1]); w.y = cvt2(x[2], x[3]); *(u32x2*)(Xb + off + bj * 128 + n * 16) = w;
                        s += (x[0] * x[0] + x[1] * x[1]) + (x[2] * x[2] + x[3] * x[3]);
                    }
                s += __shfl_xor(s, 16); s += __shfl_xor(s, 32);
                if (fq == 0) atomicAdd(ss + row, s);
            }
    }
};
struct EpiMemKV {
    static constexpr bool PERM = false, AFTER_DRAIN = false;
    float* outp; const float* rsm; bf16_t* mkv;
    __device__ __forceinline__ void operator()(const f32x4 (&acc)[2][2][4][2], const pg8::Unit& u, int wr, int wc, int fr, int fq) const {
        const int row0 = u.pm * 256 + wr * 64 + fr, col0 = u.pn * 256 + wc * 32 + 4 * fq;
#pragma unroll
        for (int ai = 0; ai < 2; ++ai)
#pragma unroll
            for (int m = 0; m < 4; ++m) {
                const int row = row0 + ai * 128 + m * 16; const float rs = rsm[row];
#pragma unroll
                for (int bj = 0; bj < 2; ++bj)
#pragma unroll
                    for (int n = 0; n < 2; ++n) {
                        const int c = col0 + bj * 128 + n * 16, l = c >> 9, kv = (c >> 8) & 1, cc = c & 255;
                        float* dst = outp + (kv ? OFF_MV : OFF_MK) + (size_t)l * (1024 * 256) + (size_t)row * 256 + cc;
                        const f32x4 v = acc[ai][bj][m][n] * rs; *(f32x4*)dst = v;
                        u32x2 w; w.x = cvt2(v[0], v[1]); w.y = cvt2(v[2], v[3]); *(u32x2*)(mkv + (size_t)row * 2048 + c) = w;
                    }
            }
    }
};
template <class Epi> __device__ __forceinline__ void run_gemm(LAS unsigned char* lds, const bf16_t* A, const bf16_t* Bt, int M, int N, int K, const Epi& E) {
    pg8::Gemm g; g.A = A; g.Bt = Bt; g.M = M; g.N = N; g.K = K;
    pg8::StaticOrder S; S.init(M, N, (int)gridDim.x, lbid());
    pg8::gemm_phase<Epi, pg8::StaticOrder, false>(lds, g, S, E, nullptr);
}

__device__ void phase0(const Params& p, LAS unsigned char* lds) {
    unsigned char* ws = p.ws; float* outp_ = p.out; asm volatile("" : "+s"(ws), "+s"(outp_)); const int z = lz();
    const int tid = ltid(), bid = lbid(), nb = gridDim.x, wid = tid >> 6, lane = tid & 63;
    LAS float* tile = (LAS float*)lds;
    for (int t = bid; t < p.ntiles; t += nb) {
        int j = 0;
        while (j + 1 < p.njobs && t >= p.jobs[j + 1].tstart) ++j;
        const float* src = p.jobs[j].src; const float* g = p.jobs[j].g; bf16_t* dst = p.jobs[j].dst; const int K = p.jobs[j].K, N = p.jobs[j].N, tl = t - p.jobs[j].tstart;
        const int ntn = N >> 6, k0 = (tl / ntn) * 64, n0 = (tl % ntn) * 64;
#pragma unroll
        for (int i = 0; i < 2; ++i) {
            const int k = (tid >> 4) + 32 * i, n4 = (tid & 15) * 4;
            const float4 v = *(const float4*)(src + (size_t)(k0 + k) * N + n0 + n4);
            const float gk = g ? g[k0 + k] : 1.0f;
            tile[k * 65 + n4 + 0] = v.x * gk; tile[k * 65 + n4 + 1] = v.y * gk; tile[k * 65 + n4 + 2] = v.z * gk; tile[k * 65 + n4 + 3] = v.w * gk;
        }
        __syncthreads();
        {
            const int n = tid >> 3, k8 = (tid & 7) * 8; u32x4 w;
            w.x = cvt2(tile[(k8 + 0) * 65 + n], tile[(k8 + 1) * 65 + n]); w.y = cvt2(tile[(k8 + 2) * 65 + n], tile[(k8 + 3) * 65 + n]);
            w.z = cvt2(tile[(k8 + 4) * 65 + n], tile[(k8 + 5) * 65 + n]); w.w = cvt2(tile[(k8 + 6) * 65 + n], tile[(k8 + 7) * 65 + n]);
            *(u32x4*)(dst + (size_t)(n0 + n) * K + k0 + k8) = w;
        }
        __syncthreads();
    }
    float* X = (float*)(ws + WS_X); bf16_t* Xb = (bf16_t*)(ws + WS_XB); float* ss = (float*)(ws + WS_SS);
    bf16_t* memb = (bf16_t*)(ws + WS_MEMB); float* rsm = (float*)(ws + WS_RSM);
    for (int row = bid * 8 + wid; row < MP + 1024; row += nb * 8) {
        const float* src = nullptr;
        if (row < NPR) src = p.in[z + 0] + (size_t)row * 1024; else if (row < MR) src = p.in[z + 1] + (size_t)(row - NPR) * 1024; else if (row >= MP) src = p.in[z + 7] + (size_t)(row - MP) * 1024;
        float s = 0.f;
#pragma unroll
        for (int i = 0; i < 4; ++i) {
            const int c = i * 256 + lane * 4;
            float4 v = src ? *(const float4*)(src + c) : make_float4(0.f, 0.f, 0.f, 0.f);
            s += v.x * v.x + v.y * v.y + v.z * v.z + v.w * v.w;
            u32x2 w; w.x = cvt2(v.x, v.y); w.y = cvt2(v.z, v.w);
            if (row < MP) { *(float4*)(X + (size_t)row * 1024 + c) = v; *(u32x2*)(Xb + (size_t)row * 1024 + c) = w; }
            else *(u32x2*)(memb + (size_t)(row - MP) * 1024 + c) = w;
        }
        s = wave_sum(s);
        if (lane == 0) { if (row < MP) ss[row] = s; else rsm[row - MP] = 1.0f / sqrtf(s * (1.0f / 1024.0f) + EPSN); }
    }
    for (int i = bid * 512 + tid; i < 8 * MP; i += nb * 512) ss[MP + i] = 0.f;
    for (int i = bid * 512 + tid; i < 2 * 128 * 127 * 64; i += nb * 512) {
        const int kv = i / (128 * 127 * 64), r = i % (128 * 127 * 64), b = r / (127 * 64), r2 = r % (127 * 64), j = r2 >> 6, c4 = r2 & 63;
        const float4 v = *(const float4*)(p.in[z + 5 + kv] + ((size_t)(b * 128 + j + 1)) * 256 + c4 * 4);
        *(float4*)(outp_ + (kv ? OFF_VS : OFF_KS) + ((size_t)(b * 128 + j)) * 256 + c4 * 4) = v;
    }
}

constexpr int RS = 136;
__device__ void ret_kvchunk_item(const Params& p, LAS unsigned char* lds, int it) {
    unsigned char* ws = p.ws; float* outp_ = p.out; asm volatile("" : "+s"(ws), "+s"(outp_)); const int z = lz();
    const int tid = ltid(), wid = tid >> 6, lane = tid & 63, fr = lane & 15, fq = lane >> 4;
    const int bh = it >> 5, n = it & 31, b = bh / 6, h = bh % 6, r0 = b * 4096 + n * 128;
    const float lg = log_gamma(h);
    const bf16_t* proj = (const bf16_t*)(ws + WS_PROJ);
    LAS bf16_t* Kt = (LAS bf16_t*)lds; LAS bf16_t* Vt = Kt + 128 * RS;
    for (int idx = tid; idx < 2048; idx += 512) {
        const int tt = idx >> 4, c8 = (idx & 15) * 8;
        const bf16_t* src = proj + (size_t)(r0 + tt) * 3328 + h * 128 + c8;
        const u32x4 kq = *(const u32x4*)(src + 768), vq = *(const u32x4*)(src + 1536);
        const float sc = expf((float)(127 - tt) * lg) * 0.08838834764831845f;
#pragma unroll
        for (int j = 0; j < 4; ++j) {
            const unsigned kw = cvt2(bflo(kq[j]) * sc, bfhi(kq[j]) * sc);
            Kt[(c8 + 2 * j) * RS + tt] = (bf16_t)(kw & 0xffffu); Kt[(c8 + 2 * j + 1) * RS + tt] = (bf16_t)(kw >> 16);
            Vt[(c8 + 2 * j) * RS + tt] = (bf16_t)(vq[j] & 0xffffu); Vt[(c8 + 2 * j + 1) * RS + tt] = (bf16_t)(vq[j] >> 16);
        }
    }
    __syncthreads();
    f32x4 acc[8];
#pragma unroll
    for (int i = 0; i < 8; ++i) acc[i] = (f32x4){0.f, 0.f, 0.f, 0.f};
#pragma unroll
    for (int ks = 0; ks < 4; ++ks) {
        const bf16x8 a = ldfrag(Kt, wid * 16 + fr, RS, ks * 32 + fq * 8);
#pragma unroll
        for (int nt = 0; nt < 8; ++nt) { const bf16x8 bb = ldfrag(Vt, nt * 16 + fr, RS, ks * 32 + fq * 8); acc[nt] = mfma16(bb, a, acc[nt]); }
    }
    float* dst = (float*)(ws + WS_KVC) + (size_t)it * 16384 + (wid * 16 + fr) * 128 + 4 * fq;
#pragma unroll
    for (int nt = 0; nt < 8; ++nt) *(f32x4*)(dst + nt * 16) = acc[nt];
    __syncthreads();
}
__device__ void ret_scan(const Params& p, int l) {
    unsigned char* ws = p.ws; float* outp_ = p.out; asm volatile("" : "+s"(ws), "+s"(outp_)); const int z = lz();
    float* kvc = (float*)(ws + WS_KVC);
    for (int idx = lbid() * 512 + ltid(); idx < 24 * 4096; idx += gridDim.x * 512) {
        const int bh = idx >> 12, c4 = idx & 4095, h = bh % 6;
        const float gc = expf(128.0f * log_gamma(h));
        float* base = kvc + (size_t)bh * 32 * 16384 + c4 * 4;
        f32x4 s = (f32x4){0.f, 0.f, 0.f, 0.f};
#pragma unroll 8
        for (int n = 0; n < 32; ++n) { const f32x4 t = *(const f32x4*)(base + (size_t)n * 16384); *(f32x4*)(base + (size_t)n * 16384) = s; s = s * gc + t; }
        *(f32x4*)(outp_ + OFF_RP + ((size_t)(l * 24 + bh)) * 16384 + c4 * 4) = s;
    }
}
__device__ void ret_out_item(const Params& p, LAS unsigned char* lds, int it) {
    unsigned char* ws = p.ws; float* outp_ = p.out; asm volatile("" : "+s"(ws), "+s"(outp_)); const int z = lz();
    const int tid = ltid(), wid = tid >> 6, lane = tid & 63, fr = lane & 15, fq = lane >> 4;
    const int bh = it >> 5, n = it & 31, b = bh / 6, h = bh % 6, r0 = b * 4096 + n * 128;
    const float lg = log_gamma(h);
    const bf16_t* proj = (const bf16_t*)(ws + WS_PROJ);
    const float* sprev = (const float*)(ws + WS_KVC) + (size_t)it * 16384;
    LAS bf16_t* Qs = (LAS bf16_t*)lds; LAS bf16_t* Ks = Qs + 128 * RS; LAS bf16_t* Vt = Ks + 128 * RS; LAS bf16_t* St = Vt + 128 * RS;
    for (int idx = tid; idx < 2048; idx += 512) {
        const int tt = idx >> 4, c8 = (idx & 15) * 8;
        const bf16_t* src = proj + (size_t)(r0 + tt) * 3328 + h * 128 + c8;
        const u32x4 qq = *(const u32x4*)(src), kq = *(const u32x4*)(src + 768), vq = *(const u32x4*)(src + 1536);
        *(LAS u32x4*)(Qs + tt * RS + c8) = qq; *(LAS u32x4*)(Ks + tt * RS + c8) = kq;
#pragma unroll
        for (int j = 0; j < 4; ++j) { Vt[(c8 + 2 * j) * RS + tt] = (bf16_t)(vq[j] & 0xffffu); Vt[(c8 + 2 * j + 1) * RS + tt] = (bf16_t)(vq[j] >> 16); }
    }
    for (int idx = tid; idx < 4096; idx += 512) {
        const int d = idx >> 5, e4 = (idx & 31) * 4;
        const f32x4 s = *(const f32x4*)(sprev + d * 128 + e4);
        const unsigned w0 = cvt2(s[0], s[1]), w1 = cvt2(s[2], s[3]);
        St[(e4 + 0) * RS + d] = (bf16_t)(w0 & 0xffffu); St[(e4 + 1) * RS + d] = (bf16_t)(w0 >> 16); St[(e4 + 2) * RS + d] = (bf16_t)(w1 & 0xffffu); St[(e4 + 3) * RS + d] = (bf16_t)(w1 >> 16);
    }
    __syncthreads();
    const int q = wid * 16 + fr;
    bf16x8 a[4];
#pragma unroll
    for (int ks = 0; ks < 4; ++ks) a[ks] = ldfrag(Qs, q, RS, ks * 32 + fq * 8);
    f32x4 acc[8];
#pragma unroll
    for (int i = 0; i < 8; ++i) acc[i] = (f32x4){0.f, 0.f, 0.f, 0.f};
#pragma unroll
    for (int ks = 0; ks < 4; ++ks)
#pragma unroll
        for (int nt = 0; nt < 8; ++nt) acc[nt] = mfma16(ldfrag(St, nt * 16 + fr, RS, ks * 32 + fq * 8), a[ks], acc[nt]);
    const float wq = expf((float)(q + 1) * lg);
#pragma unroll
    for (int i = 0; i < 8; ++i) acc[i] *= wq;
    __syncthreads();
#pragma unroll
    for (int nt = 0; nt < 8; ++nt) {
        f32x4 sc = (f32x4){0.f, 0.f, 0.f, 0.f};
#pragma unroll
        for (int ks = 0; ks < 4; ++ks) sc = mfma16(ldfrag(Ks, nt * 16 + fr, RS, ks * 32 + fq * 8), a[ks], sc);
        float pv[4];
#pragma unroll
        for (int j = 0; j < 4; ++j) { const int diff = q - (nt * 16 + 4 * fq + j); pv[j] = diff >= 0 ? sc[j] * 0.08838834764831845f * expf((float)diff * lg) : 0.f; }
        u32x2 w; w.x = cvt2(pv[0], pv[1]); w.y = cvt2(pv[2], pv[3]);
        *(LAS u32x2*)(Qs + q * RS + nt * 16 + 4 * fq) = w;
    }
    __syncthreads();
#pragma unroll
    for (int ks = 0; ks < 4; ++ks) {
        const bf16x8 pa = ldfrag(Qs, q, RS, ks * 32 + fq * 8);
#pragma unroll
        for (int nt = 0; nt < 8; ++nt) acc[nt] = mfma16(ldfrag(Vt, nt * 16 + fr, RS, ks * 32 + fq * 8), pa, acc[nt]);
    }
    float s = 0.f;
#pragma unroll
    for (int i = 0; i < 8; ++i) s += (acc[i][0] + acc[i][1]) + (acc[i][2] + acc[i][3]);
    s += __shfl_xor(s, 16); s += __shfl_xor(s, 32);
    const float mu = s * (1.0f / 128.0f);
    float v = 0.f;
#pragma unroll
    for (int i = 0; i < 8; ++i) { const f32x4 d = acc[i] - mu; v += (d[0] * d[0] + d[1] * d[1]) + (d[2] * d[2] + d[3] * d[3]); }
    v += __shfl_xor(v, 16); v += __shfl_xor(v, 32);
    const float rstd = 1.0f / sqrtf(v * (1.0f / 128.0f) + EPSN);
    const bf16_t* gp = proj + (size_t)(r0 + q) * 3328 + 2304 + h * 128 + 4 * fq;
    bf16_t* op = (bf16_t*)(ws + WS_O) + (size_t)(r0 + q) * 1024 + h * 128 + 4 * fq;
#pragma unroll
    for (int nt = 0; nt < 8; ++nt) {
        const u32x2 gw = *(const u32x2*)(gp + nt * 16);
        const float g0 = bflo(gw.x), g1 = bfhi(gw.x), g2 = bflo(gw.y), g3 = bfhi(gw.y);
        const float o0 = (acc[nt][0] - mu) * rstd * (g0 / (1.0f + expf(-g0))), o1 = (acc[nt][1] - mu) * rstd * (g1 / (1.0f + expf(-g1)));
        const float o2 = (acc[nt][2] - mu) * rstd * (g2 / (1.0f + expf(-g2))), o3 = (acc[nt][3] - mu) * rstd * (g3 / (1.0f + expf(-g3)));
        u32x2 w; w.x = cvt2(o0, o1); w.y = cvt2(o2, o3);
        *(u32x2*)(op + nt * 16) = w;
    }
    __syncthreads();
}

constexpr int QS_ = 72, VS_ = 264;
__device__ void attn_tile(LAS unsigned char* lds, const bf16_t* Q, int ldq, const float* Kf, const float* Vf, int ldf, const bf16_t* Kb, const bf16_t* Vb, int ldb, int kv0,
                          int swa, float slope, float sink, bf16_t* O) {
    const int tid = ltid(), wid = tid >> 6, lane = tid & 63, fr = lane & 15, fq = lane >> 4;
    LAS bf16_t* Qs = (LAS bf16_t*)lds; LAS bf16_t* Ks = Qs + 128 * QS_; LAS bf16_t* Vt = Ks + 256 * QS_;
    for (int idx = tid; idx < 1024; idx += 512) { const int r = idx >> 3, c8 = (idx & 7) * 8; *(LAS u32x4*)(Qs + r * QS_ + c8) = *(const u32x4*)(Q + (size_t)r * ldq + c8); }
    if (Kf) {
        for (int idx = tid; idx < 4096; idx += 512) {
            const int r = idx >> 4, c4 = (idx & 15) * 4;
            const float4 k = *(const float4*)(Kf + (size_t)r * ldf + c4), v = *(const float4*)(Vf + (size_t)r * ldf + c4);
            u32x2 w; w.x = cvt2(k.x, k.y); w.y = cvt2(k.z, k.w); *(LAS u32x2*)(Ks + r * QS_ + c4) = w;
            const unsigned v0 = cvt2(v.x, v.y), v1 = cvt2(v.z, v.w);
            Vt[(c4 + 0) * VS_ + r] = (bf16_t)(v0 & 0xffffu); Vt[(c4 + 1) * VS_ + r] = (bf16_t)(v0 >> 16); Vt[(c4 + 2) * VS_ + r] = (bf16_t)(v1 & 0xffffu); Vt[(c4 + 3) * VS_ + r] = (bf16_t)(v1 >> 16);
        }
    } else {
        for (int idx = tid; idx < 2048; idx += 512) {
            const int r = idx >> 3, c8 = (idx & 7) * 8;
            u32x4 kq = (u32x4){0u, 0u, 0u, 0u}, vq = (u32x4){0u, 0u, 0u, 0u};
            if (r >= kv0) { kq = *(const u32x4*)(Kb + (ptrdiff_t)r * ldb + c8); vq = *(const u32x4*)(Vb + (ptrdiff_t)r * ldb + c8); }
            *(LAS u32x4*)(Ks + r * QS_ + c8) = kq;
#pragma unroll
            for (int j = 0; j < 4; ++j) { Vt[(c8 + 2 * j) * VS_ + r] = (bf16_t)(vq[j] & 0xffffu); Vt[(c8 + 2 * j + 1) * VS_ + r] = (bf16_t)(vq[j] >> 16); }
        }
    }
    __syncthreads();
    const int q = wid * 16 + fr;
    const bf16x8 a0 = ldfrag(Qs, q, QS_, fq * 8), a1 = ldfrag(Qs, q, QS_, 32 + fq * 8);
    f32x4 sc[16];
    float mx = swa ? sink : -INFINITY;
#pragma unroll
    for (int nt = 0; nt < 16; ++nt) {
        f32x4 s = (f32x4){0.f, 0.f, 0.f, 0.f};
        s = mfma16(ldfrag(Ks, nt * 16 + fr, QS_, fq * 8), a0, s);
        s = mfma16(ldfrag(Ks, nt * 16 + fr, QS_, 32 + fq * 8), a1, s);
#pragma unroll
        for (int j = 0; j < 4; ++j) {
            float v = s[j] * 0.125f;
            if (swa) { const int kk = nt * 16 + 4 * fq + j, dist = 128 + q - kk; v = (dist >= 0 && dist <= 128 && kk >= kv0) ? v - slope * (float)dist : -INFINITY; }
            s[j] = v; mx = fmaxf(mx, v);
        }
        sc[nt] = s;
    }
    mx = fmaxf(mx, __shfl_xor(mx, 16)); mx = fmaxf(mx, __shfl_xor(mx, 32));
    float sum = 0.f;
#pragma unroll
    for (int nt = 0; nt < 16; ++nt)
#pragma unroll
        for (int j = 0; j < 4; ++j) { const float e = __expf(sc[nt][j] - mx); sc[nt][j] = e; sum += e; }
    sum += __shfl_xor(sum, 16); sum += __shfl_xor(sum, 32);
    if (swa) sum += __expf(sink - mx);
    const float inv = 1.0f / sum;
    __syncthreads();
    LAS bf16_t* Ps = Ks;
    f32x4 acc[4];
#pragma unroll
    for (int i = 0; i < 4; ++i) acc[i] = (f32x4){0.f, 0.f, 0.f, 0.f};
#pragma unroll
    for (int hf = 0; hf < 2; ++hf) {
#pragma unroll
        for (int nt = 0; nt < 8; ++nt) { const f32x4 e = sc[hf * 8 + nt] * inv; u32x2 w; w.x = cvt2(e[0], e[1]); w.y = cvt2(e[2], e[3]); *(LAS u32x2*)(Ps + q * RS + nt * 16 + 4 * fq) = w; }
        __syncthreads();
#pragma unroll
        for (int ks = 0; ks < 4; ++ks) {
            const bf16x8 pa = ldfrag(Ps, q, RS, ks * 32 + fq * 8);
#pragma unroll
            for (int nt = 0; nt < 4; ++nt) acc[nt] = mfma16(ldfrag(Vt, nt * 16 + fr, VS_, hf * 128 + ks * 32 + fq * 8), pa, acc[nt]);
        }
        __syncthreads();
    }
#pragma unroll
    for (int nt = 0; nt < 4; ++nt) { u32x2 w; w.x = cvt2(acc[nt][0], acc[nt][1]); w.y = cvt2(acc[nt][2], acc[nt][3]); *(u32x2*)(O + (size_t)q * 1024 + nt * 16 + 4 * fq) = w; }
    __syncthreads();
}
__device__ void mem_attn_prompt_item(const Params& p, LAS unsigned char* lds, int l, int it, int ldq, int qoff) {
    unsigned char* ws = p.ws; float* outp_ = p.out; asm volatile("" : "+s"(ws), "+s"(outp_)); const int z = lz();
    const int qt = it & 31, h = (it >> 5) & 3, b = it >> 7;
    const bf16_t* Q = (const bf16_t*)(ws + WS_PROJ) + (size_t)(b * 4096 + qt * 128) * ldq + qoff + h * 64;
    const bf16_t* Kb = (const bf16_t*)(ws + WS_MKV) + (size_t)(b * 256) * 2048 + l * 512 + h * 64;
    bf16_t* O = (bf16_t*)(ws + WS_O) + (size_t)(b * 4096 + qt * 128) * 1024 + 768 + h * 64;
    attn_tile(lds, Q, ldq, nullptr, nullptr, 0, Kb, Kb + 256, 2048, 0, 0, 0.f, 0.f, O);
}
__device__ void swa_prompt_item(const Params& p, LAS unsigned char* lds, int j, int it, int ldq) {
    unsigned char* ws = p.ws; float* outp_ = p.out; asm volatile("" : "+s"(ws), "+s"(outp_)); const int z = lz();
    const int hq = it % 12, nbk = (it / 12) & 31, b = it / (12 * 32), g = hq / 3;
    const bf16_t* Q = (const bf16_t*)(ws + WS_PROJ) + (size_t)(b * 4096 + nbk * 128) * ldq + hq * 64;
    const bf16_t* kvs = (const bf16_t*)(ws + WS_KVS);
    const bf16_t* Kb = kvs + ((ptrdiff_t)(b * 4096 + nbk * 128 - 128)) * 512 + g * 64;
    bf16_t* O = (bf16_t*)(ws + WS_O) + (size_t)(b * 4096 + nbk * 128) * 1024 + hq * 64;
    attn_tile(lds, Q, ldq, nullptr, nullptr, 0, Kb, Kb + 256, 512, nbk == 0 ? 128 : 0, 1, alibi_slope(hq), p.in[z + 13][j * 12 + hq], O);
}

__device__ float block_max(LAS float* red, float v) {
    v = wave_max(v); __syncthreads(); if ((threadIdx.x & 63) == 0) red[threadIdx.x >> 6] = v; __syncthreads();
    float r = red[0];
#pragma unroll
    for (int i = 1; i < 8; ++i) r = fmaxf(r, red[i]);
    return r;
}
__device__ float block_sum(LAS float* red, float v) {
    v = wave_sum(v); __syncthreads(); if ((threadIdx.x & 63) == 0) red[threadIdx.x >> 6] = v; __syncthreads();
    float r = 0.f;
#pragma unroll
    for (int i = 0; i < 8; ++i) r += red[i];
    return r;
}
__device__ void decode_attn(LAS unsigned char* lds, const bf16_t* q, const float* K, const float* V, int ldk, int nk, const bf16_t* kx, const bf16_t* vx,
                            int swa, float slope, float sink, bf16_t* out) {
    const int tid = ltid(), wid = tid >> 6, lane = tid & 63;
    LAS float* qs = (LAS float*)lds; LAS float* sc = qs + 64; LAS float* part = sc + 264; LAS float* red = part + 2048;
    if (tid < 64) qs[tid] = bf2f(q[tid]);
    __syncthreads();
    {
        const int m = tid >> 1, half = tid & 1; float s = 0.f;
        if (m < nk) {
            const float* kp = K + (size_t)m * ldk + half * 32;
#pragma unroll
            for (int i = 0; i < 8; ++i) { const float4 kv = *(const float4*)(kp + i * 4); const LAS float* qq = qs + half * 32 + i * 4; s += kv.x * qq[0] + kv.y * qq[1] + kv.z * qq[2] + kv.w * qq[3]; }
        }
        s += __shfl_xor(s, 1);
        if (m < nk && half == 0) { float v = s * 0.125f; if (swa) v -= slope * (float)(nk - m); sc[m] = v; }
        if (kx && wid == 7) { float v = wave_sum(qs[lane] * bf2f(kx[lane])); if (lane == 0) sc[nk] = v * 0.125f; }
    }
    __syncthreads();
    const int ntot = nk + (kx ? 1 : 0);
    float v = tid < ntot ? sc[tid] : -INFINITY;
    float mx = block_max(red, v);
    if (swa) mx = fmaxf(mx, sink);
    const float e = tid < ntot ? expf(v - mx) : 0.f;
    if (tid < ntot) sc[tid] = e;
    float sum = block_sum(red, e);
    if (swa) sum += expf(sink - mx);
    __syncthreads();
    {
        const int d4 = (tid & 15) * 4, mg = tid >> 4; f32x4 acc = (f32x4){0.f, 0.f, 0.f, 0.f};
        for (int m = mg; m < nk; m += 32) { const f32x4 vv = *(const f32x4*)(V + (size_t)m * ldk + d4); acc += vv * sc[m]; }
        if (vx && mg == 0) { const float pe = sc[nk]; acc[0] += pe * bf2f(vx[d4]); acc[1] += pe * bf2f(vx[d4 + 1]); acc[2] += pe * bf2f(vx[d4 + 2]); acc[3] += pe * bf2f(vx[d4 + 3]); }
        part[mg * 64 + d4 + 0] = acc[0]; part[mg * 64 + d4 + 1] = acc[1]; part[mg * 64 + d4 + 2] = acc[2]; part[mg * 64 + d4 + 3] = acc[3];
    }
    __syncthreads();
    if (tid < 64) { float s = 0.f;
#pragma unroll
        for (int i = 0; i < 32; ++i) s += part[i * 64 + tid];
        out[tid] = f2bf(s / sum); }
    __syncthreads();
}
__device__ void mem_decode_item(const Params& p, LAS unsigned char* lds, int l, int it, int ldq, int qoff) {
    unsigned char* ws = p.ws; float* outp_ = p.out; asm volatile("" : "+s"(ws), "+s"(outp_)); const int z = lz();
    const int h = it & 3, b = it >> 2;
    const bf16_t* q = (const bf16_t*)(ws + WS_PROJ) + (size_t)(NPR + b) * ldq + qoff + h * 64;
    const size_t base = ((size_t)(l * 128 + b) * 256) * 256 + h * 64;
    decode_attn(lds, q, p.in[z + 2] + base, p.in[z + 3] + base, 256, 256, nullptr, nullptr, 0, 0.f, 0.f, (bf16_t*)(ws + WS_O) + (size_t)(NPR + b) * 1024 + 768 + h * 64);
}
__device__ void swa_decode_item(const Params& p, LAS unsigned char* lds, int j, int it, int ldq) {
    unsigned char* ws = p.ws; float* outp_ = p.out; asm volatile("" : "+s"(ws), "+s"(outp_)); const int z = lz();
    const int hq = it % 12, b = it / 12, g = hq / 3;
    const bf16_t* q = (const bf16_t*)(ws + WS_PROJ) + (size_t)(NPR + b) * ldq + hq * 64;
    const size_t base = ((size_t)b * 128) * 256 + g * 64;
    const bf16_t* kx = (const bf16_t*)(ws + WS_KVS) + (size_t)(NPR + b) * 512 + g * 64;
    decode_attn(lds, q, p.in[z + 5] + base, p.in[z + 6] + base, 256, 128, kx, kx + 256, 1, alibi_slope(hq), p.in[z + 13][j * 12 + hq], (bf16_t*)(ws + WS_O) + (size_t)(NPR + b) * 1024 + hq * 64);
}
__device__ void ret_decode_item(const Params& p, LAS unsigned char* lds, int l, int it) {
    unsigned char* ws = p.ws; float* outp_ = p.out; asm volatile("" : "+s"(ws), "+s"(outp_)); const int z = lz();
    const int tid = ltid(), h = it % 6, b = it / 6;
    const float gamma = 1.0f - exp2f(-5.0f - (float)h);
    const bf16_t* pr = (const bf16_t*)(ws + WS_PROJ) + (size_t)(NPR + b) * 3328 + h * 128;
    LAS float* qs = (LAS float*)lds; LAS float* ks = qs + 128; LAS float* vs = ks + 128; LAS float* gs = vs + 128; LAS float* part = gs + 128; LAS float* os = part + 2048;
    { const int w = tid >> 7, e = tid & 127; const float v = bf2f(pr[w * 768 + e]); (w == 0 ? qs : w == 1 ? ks : w == 2 ? vs : gs)[e] = (w == 1) ? v * 0.08838834764831845f : v; }
    __syncthreads();
    const size_t sb = ((size_t)((l * 128 + b) * 6 + h)) * 16384;
    const float* S0 = p.in[z + 4] + sb; float* S1 = outp_ + OFF_RS + sb;
    const int e4 = (tid & 31) * 4, dg = tid >> 5;
    const f32x4 vv = (f32x4){vs[e4], vs[e4 + 1], vs[e4 + 2], vs[e4 + 3]};
    f32x4 o = (f32x4){0.f, 0.f, 0.f, 0.f};
#pragma unroll
    for (int i = 0; i < 8; ++i) { const int d = dg + 16 * i; f32x4 s = *(const f32x4*)(S0 + d * 128 + e4) * gamma + vv * ks[d]; *(f32x4*)(S1 + d * 128 + e4) = s; o += s * qs[d]; }
    part[dg * 128 + e4] = o[0]; part[dg * 128 + e4 + 1] = o[1]; part[dg * 128 + e4 + 2] = o[2]; part[dg * 128 + e4 + 3] = o[3];
    __syncthreads();
    if (tid < 128) { float s = 0.f;
#pragma unroll
        for (int i = 0; i < 16; ++i) s += part[i * 128 + tid];
        os[tid] = s; }
    __syncthreads();
    if (tid < 128) {
        float mu = 0.f; for (int i = 0; i < 128; ++i) mu += os[i]; mu *= (1.0f / 128.0f);
        float var = 0.f; for (int i = 0; i < 128; ++i) { const float d = os[i] - mu; var += d * d; } var *= (1.0f / 128.0f);
        const float g = gs[tid];
        ((bf16_t*)(ws + WS_O))[(size_t)(NPR + b) * 1024 + h * 128 + tid] = f2bf((os[tid] - mu) / sqrtf(var + EPSN) * (g / (1.0f + expf(-g))));
    }
    __syncthreads();
}


#define XB_TMO      128
#define XB_XCNT(j)  (256  + 64 * (j))
#define XB_XSUB(j)  (1280 + 64 * (j))
#define XB_XGEN(j)  (2304 + 64 * (j))
#define XB_TOP      3328
#define XB_TOPGEN   3392
#define XCD_BAR_WORDS 3456
#define XB_SPIN_CAP (1u << 18)
__device__ __forceinline__ unsigned xb_ld(unsigned* p)              { return __hip_atomic_load(p, __ATOMIC_RELAXED, __HIP_MEMORY_SCOPE_AGENT); }
__device__ __forceinline__ unsigned xb_add(unsigned* p, unsigned v) { return __hip_atomic_fetch_add(p, v, __ATOMIC_RELAXED, __HIP_MEMORY_SCOPE_AGENT); }
__device__ __forceinline__ unsigned xb_xcc_id() { return (unsigned)__builtin_amdgcn_s_getreg((3 << 11) | 20) & 0xFu; }
#define XB_SPIN(cond, bar) do { unsigned _sp = 0; while (cond) { __builtin_amdgcn_s_sleep(1); \
    if ((++_sp & 255u) == 0u) { if (xb_ld(&(bar)[XB_TMO])) break; if (_sp > XB_SPIN_CAP) { atomicAdd(&(bar)[XB_TMO], 1u); break; } } } } while (0)

struct XcdBarrier {
    unsigned* bar; unsigned x;
    volatile LAS unsigned* st;
};

__device__ __forceinline__ XcdBarrier xcd_barrier_post(unsigned* bar, volatile LAS unsigned* st) {
    XcdBarrier b; b.bar = bar; b.x = xb_xcc_id(); b.st = st;
    if (threadIdx.x == 0) (void)xb_add(&bar[XB_XCNT(b.x)], 1u);
    return b;
}
__device__ __forceinline__ void xcd_barrier_complete(unsigned* bar, unsigned x, unsigned& nloc, unsigned& nx) {
    const unsigned G = gridDim.x * gridDim.y * gridDim.z;
    unsigned sum, cnt, mine, sp = 0u;
    for (;;) {
        sum = 0u; cnt = 0u; mine = 0u;
#pragma unroll
        for (unsigned j = 0; j < 16; ++j) { const unsigned c = xb_ld(&bar[XB_XCNT(j)]); sum += c; cnt += (c > 0u) ? 1u : 0u; mine = (j == x) ? c : mine; }
        if (sum == G) break;
        __builtin_amdgcn_s_sleep(1);
        if ((++sp & 255u) == 0u) { if (xb_ld(&bar[XB_TMO])) break; if (sp > XB_SPIN_CAP) { atomicAdd(&bar[XB_TMO], 1u); break; } }
    }
    nloc = mine > 0u ? mine : 1u; nx = cnt > 0u ? cnt : 1u;
}

__device__ __forceinline__ void xcd_barrier(const XcdBarrier& b) {
    asm volatile("s_waitcnt vmcnt(0)" ::: "memory");
    __syncthreads();
    if (threadIdx.x == 0) {
        unsigned* bar = b.bar;
        __builtin_amdgcn_s_waitcnt(0);
        unsigned nloc = b.st[0], nx = b.st[1];
        if (nloc == 0u) { xcd_barrier_complete(bar, b.x, nloc, nx); b.st[0] = nloc; b.st[1] = nx; }
        const unsigned old = xb_add(&bar[XB_XSUB(b.x)], 1u);
        const unsigned gen = old / nloc;
        if (old + 1u == (gen + 1u) * nloc) {
            __builtin_amdgcn_fence(__ATOMIC_RELEASE, "agent");
            asm volatile("s_waitcnt vmcnt(0)" ::: "memory");
            const unsigned og = xb_add(&bar[XB_TOP], 1u);
            const unsigned tg = og / nx;
            if (og + 1u == (tg + 1u) * nx) xb_add(&bar[XB_TOPGEN], 1u);
            else XB_SPIN(xb_ld(&bar[XB_TOPGEN]) == tg, bar);
            __builtin_amdgcn_fence(__ATOMIC_ACQUIRE, "agent");
            xb_add(&bar[XB_XGEN(b.x)], 1u);
            asm volatile("s_waitcnt vmcnt(0)" ::: "memory");
        } else {
            XB_SPIN(xb_ld(&bar[XB_XGEN(b.x)]) == gen, bar);
            __builtin_amdgcn_fence(__ATOMIC_ACQUIRE, "agent");
            asm volatile("s_waitcnt vmcnt(0)" ::: "memory");
        }
    }
    __syncthreads();
}
__device__ void run_phase(const Params& p, LAS unsigned char* lds, int ph) {
    unsigned char* ws = p.ws; float* outp_ = p.out; asm volatile("" : "+s"(ws), "+s"(outp_)); const int z = lz();
    const int bid = lbid(), nb = gridDim.x;
    float* X = (float*)(ws + WS_X); bf16_t* Xb = (bf16_t*)(ws + WS_XB); float* ss = (float*)(ws + WS_SS);
    bf16_t* proj = (bf16_t*)(ws + WS_PROJ); bf16_t* Ob = (bf16_t*)(ws + WS_O);
    if (ph == 0) { phase0(p, lds); return; }
    if (ph == 25) {
        const int wid = threadIdx.x >> 6, lane = threadIdx.x & 63;
        for (int row = bid * 8 + wid; row < MR; row += nb * 8) {
            const float rs = 1.0f / sqrtf(ss[8 * MP + row] * (1.0f / 1024.0f) + EPSN);
#pragma unroll
            for (int i = 0; i < 4; ++i) { const int c = i * 256 + lane * 4; const f32x4 v = *(const f32x4*)(X + (size_t)row * 1024 + c), g = *(const f32x4*)(p.in[z + 21] + c); *(f32x4*)(outp_ + (size_t)row * 1024 + c) = v * rs * g; }
        }
        return;
    }
    int l, sub; bool isA;
    if (ph < 15) { isA = true; l = (ph - 1) / 7; sub = (ph - 1) % 7; } else { isA = false; l = 2 + (ph - 15) / 5; sub = (ph - 15) % 5; }
    const int gsub = isA ? sub : (sub == 0 ? 0 : sub == 1 ? 3 : sub + 2);
    const float* ss_mix = ss + (size_t)(2 * l) * MP; float* ss_mlp = ss + (size_t)(2 * l + 1) * MP; float* ss_next = ss + (size_t)(2 * l + 2) * MP;
    if (gsub == 0) {
        if (isA) {
            EpiProj<0, 0> E; E.O = proj; E.ldc = 3328; E.ss = ss_mix; E.O2 = nullptr; E.outp = nullptr;
            run_gemm(lds, Xb, (const bf16_t*)(ws + WS_WINA) + (size_t)l * 3328 * 1024, MP, 3328, 1024, E);
            if (l == 0) { EpiMemKV M; M.outp = outp_; M.rsm = (const float*)(ws + WS_RSM); M.mkv = (bf16_t*)(ws + WS_MKV); run_gemm(lds, (const bf16_t*)(ws + WS_MEMB), (const bf16_t*)(ws + WS_WMEM), 1024, 2048, 1024, M); }
        } else if (l == 2) {
            EpiProj<0, 1> E; E.O = proj; E.ldc = 1024; E.ss = ss_mix; E.O2 = (bf16_t*)(ws + WS_KVS); E.outp = outp_;
            run_gemm(lds, Xb, (const bf16_t*)(ws + WS_WINB0), MP, 1536, 1024, E);
        } else {
            EpiProj<0, 0> E; E.O = proj; E.ldc = 1024; E.ss = ss_mix; E.O2 = nullptr; E.outp = nullptr;
            run_gemm(lds, Xb, (const bf16_t*)(ws + WS_WINB1), MP, 1024, 1024, E);
        }
    } else if (gsub == 1) {
        for (int it = bid; it < 768; it += nb) ret_kvchunk_item(p, lds, it);
        for (int it = bid; it < 768; it += nb) ret_decode_item(p, lds, l, it);
        for (int it = bid; it < 512; it += nb) mem_decode_item(p, lds, l, it, 3328, 3072);
    } else if (gsub == 2) {
        ret_scan(p, l);
    } else if (gsub == 3) {
        if (isA) {
            for (int it = bid; it < 768; it += nb) ret_out_item(p, lds, it);
            for (int it = bid; it < 512; it += nb) mem_attn_prompt_item(p, lds, l, it, 3328, 3072);
        } else {
            for (int it = bid; it < 1536; it += nb) swa_prompt_item(p, lds, l - 2, it, 1024);
            for (int it = bid; it < 512; it += nb) mem_attn_prompt_item(p, lds, l, it, 1024, 768);
            for (int it = bid; it < 1536; it += nb) swa_decode_item(p, lds, l - 2, it, 1024);
            for (int it = bid; it < 512; it += nb) mem_decode_item(p, lds, l, it, 1024, 768);
        }
    } else if (gsub == 4) {
        EpiResid E; E.X = X; E.Xb = Xb; E.ss = ss_mlp;
        run_gemm(lds, Ob, (const bf16_t*)(ws + WS_WOUT) + (size_t)l * 1024 * 1024, MP, 1024, 1024, E);
    } else if (gsub == 5) {
        EpiProj<1, 0> E; E.O = proj; E.ldc = 4096; E.ss = ss_mlp; E.O2 = nullptr; E.outp = nullptr;
        run_gemm(lds, Xb, (const bf16_t*)(ws + WS_WUP) + (size_t)l * 4096 * 1024, MP, 4096, 1024, E);
    } else {
        EpiResid E; E.X = X; E.Xb = Xb; E.ss = ss_next;
        run_gemm(lds, proj, (const bf16_t*)(ws + WS_WDOWN) + (size_t)l * 4096 * 1024, MP, 1024, 4096, E);
    }
}

__global__ __launch_bounds__(512, 2) void fwd_megakernel(Params p) {
    extern __shared__ __attribute__((aligned(16))) unsigned char shm[];
    LAS unsigned char* lds = (LAS unsigned char*)shm;
    volatile LAS unsigned* st = (volatile LAS unsigned*)(lds + (LDS_BYTES - 16));
    if (threadIdx.x == 0) { st[0] = 0u; st[1] = 0u; }
    __syncthreads();
    const bool multi = (p.ph_hi - p.ph_lo) > 1;
    XcdBarrier xb;
    if (multi) {
        cg::grid_group grid = cg::this_grid();
        xb = xcd_barrier_post((unsigned*)(p.ws + WS_BAR), st);
        grid.sync();
    }
    for (int ph = p.ph_lo; ph < p.ph_hi; ++ph) {
        run_phase(p, lds, ph);
        if (ph + 1 < p.ph_hi) xcd_barrier(xb);
    }
}

extern "C" void kernel_launch(void* const* d_in, const int* in_sizes, int n_in, void* d_out, int out_size, void* d_ws, size_t ws_size, hipStream_t stream) {
    static int grid = 0;
    if (grid == 0) {
        int dev = 0, cus = 0, per_cu = 0;
        hipGetDevice(&dev); hipDeviceGetAttribute(&cus, hipDeviceAttributeMultiprocessorCount, dev);
        if (hipFuncSetAttribute((const void*)fwd_megakernel, hipFuncAttributeMaxDynamicSharedMemorySize, LDS_BYTES) != hipSuccess) { fprintf(stderr, "hipFuncSetAttribute failed\n"); }
        hipOccupancyMaxActiveBlocksPerMultiprocessor(&per_cu, (const void*)fwd_megakernel, 512, LDS_BYTES);
        if (per_cu < 1) per_cu = 1;
        grid = cus * per_cu; (void)hipGetLastError();
        if (ws_size < WS_END) { fprintf(stderr, "workspace too small: %zu < %zu\n", ws_size, (size_t)WS_END); grid = -1; }
    }
    if (grid < 0) return;
    Params p; memset(&p, 0, sizeof(p));
    for (int i = 0; i < 22; ++i) p.in[i] = (const float*)d_in[i];
    p.out = (float*)d_out; p.ws = (unsigned char*)d_ws;
    unsigned char* ws = (unsigned char*)d_ws;
    int nj = 0, ts = 0;
    auto add = [&](const float* src, const float* g, size_t dst_off, int K, int N) {
        Job& j = p.jobs[nj++]; j.src = src; j.g = g; j.dst = (bf16_t*)(ws + dst_off); j.K = K; j.N = N; j.tstart = ts; j.pad = 0; ts += (K / 64) * (N / 64); };
    const float* nmix = p.in[8]; const float* nmem = p.in[14]; const float* nmlp = p.in[18];
    for (int l = 0; l < 4; ++l) add(p.in[19] + (size_t)l * 1024 * 4096, nmlp + l * 1024, WS_WUP + (size_t)l * 4096 * 1024 * 2, 1024, 4096);
    for (int l = 0; l < 4; ++l) add(p.in[20] + (size_t)l * 4096 * 1024, nullptr, WS_WDOWN + (size_t)l * 4096 * 1024 * 2, 4096, 1024);
    for (int l = 0; l < 2; ++l) add(p.in[9] + (size_t)l * 1024 * 3328, nmix + l * 1024, WS_WINA + (size_t)l * 3328 * 1024 * 2, 1024, 3328);
    for (int l = 0; l < 2; ++l) add(p.in[10] + (size_t)l * 1024 * 1024, nullptr, WS_WOUT + (size_t)l * 1024 * 1024 * 2, 1024, 1024);
    for (int l = 0; l < 2; ++l) add(p.in[12] + (size_t)l * 1024 * 1024, nullptr, WS_WOUT + (size_t)(2 + l) * 1024 * 1024 * 2, 1024, 1024);
    add(p.in[11], nmix + 2 * 1024, WS_WINB0, 1024, 1024);
    add(p.in[17], p.in[16], WS_WINB0 + 1024ull * 1024 * 2, 1024, 512);
    add(p.in[11] + 1024 * 1024, nmix + 3 * 1024, WS_WINB1, 1024, 1024);
    for (int l = 0; l < 4; ++l) add(p.in[15] + (size_t)l * 1024 * 512, nmem + l * 1024, WS_WMEM + (size_t)l * 512 * 1024 * 2, 1024, 512);
    p.njobs = nj; p.ntiles = ts;
#ifdef MULTI_LAUNCH
    for (int ph = 0; ph < NPHASE; ++ph) { p.ph_lo = ph; p.ph_hi = ph + 1; hipLaunchKernelGGL(fwd_megakernel, dim3(grid), dim3(512), LDS_BYTES, stream, p); }
#else
    p.ph_lo = 0; p.ph_hi = NPHASE;
    (void)hipMemsetAsync(ws + WS_BAR, 0, 16384, stream);
    void* args[] = {&p};
    hipError_t e = hipLaunchCooperativeKernel((const void*)fwd_megakernel, dim3(grid), dim3(512), args, LDS_BYTES, stream);
    if (e != hipSuccess) fprintf(stderr, "cooperative launch failed: %s (grid %d)\n", hipGetErrorString(e), grid);
#endif
}
```

```cpp
#include <hip/hip_runtime.h>
#include <hip/hip_cooperative_groups.h>
#include <cstdio>
#include <cstring>
namespace cg = cooperative_groups;
namespace pg8 {
#define PG8_LAS __attribute__((address_space(3)))
typedef unsigned short bf16_t;
typedef short bf16x8 __attribute__((ext_vector_type(8)));
typedef float f32x4 __attribute__((ext_vector_type(4)));
typedef unsigned u32x4 __attribute__((ext_vector_type(4)));
constexpr int BM = 256, BK = 64, HALF = 128, HTB = HALF * BK * 2  , STAGE_BYTES = 8 * HTB, NXCD = 8, WGM = 8;

__host__ __device__ __forceinline__ int lds_byte(int r, int c) { const int st = (r >> 4) * 2 + (c >> 5), rr = r & 15, cc = c & 31, ob = rr * 64 + cc * 2; return st * 1024 + (ob ^ (((ob >> 9) & 1) << 5)); }
__host__ __device__ __forceinline__ void stage_rc(int b, int& R, int& C) { const int st = b / 1024, sb = b % 1024, swz = sb ^ (((sb >> 9) & 1) << 5); R = (st >> 1) * 16 + swz / 64; C = (st & 1) * 32 + (swz % 64) / 2; }
__host__ __device__ __forceinline__ int perm32(int rho) { const int n = rho >> 4, i = rho & 15; return 8 * (i >> 2) + 4 * n + (i & 3); }

struct Unit { int pm, pn; };
struct Gemm { const bf16_t* A; const bf16_t* Bt; int M, N, K; };

struct StaticOrder {
    int nM, nN, nwg, G, c;
    __host__ __device__ void init(int M, int N, int G_, int c_) { nM = M / BM; nN = N / BM; nwg = nM * nN; G = G_; c = c_; }
    __host__ __device__ bool next(int i, Unit& u) const {
        const long L = (long)i * G + c; if (L >= nwg) return false;
        int wgid = (int)L; { const int q = nwg / NXCD, r = nwg % NXCD, xcd = wgid % NXCD, off = wgid / NXCD; wgid = (xcd < r ? xcd * (q + 1) : r * (q + 1) + (xcd - r) * q) + off; }
        const int nig = WGM * nN, gid = wgid / nig, fm = gid * WGM, gsz = (nM - fm) < WGM ? (nM - fm) : WGM;
        u.pm = fm + ((wgid % nig) % gsz); u.pn = (wgid % nig) / gsz; return true;
    }
    __device__ __forceinline__ void a_ready(const Unit&) const {}
    __device__ __forceinline__ void done(const Unit&) const {}
};
template <class Epi, class Sched, bool STAMP = false>
__device__ __forceinline__ void gemm_phase(PG8_LAS unsigned char* lds, const Gemm g, const Sched& S, const Epi& E, unsigned long long* stamps) {
    int tid_ = threadIdx.x; asm volatile("" : "+v"(tid_)); const int tid = tid_, wid = __builtin_amdgcn_readfirstlane(tid >> 6), lane = tid & 63, wr = wid >> 2, wc = wid & 3, fr = lane & 15, fq = lane >> 4;
    const int K = g.K, nt = K / BK;
    int ts_lo = 0, ts_hi = 0, nts = 0; const unsigned long long rt_entry = STAMP ? (unsigned long long)wall_clock64() : 0ull;
#define PG8_STAMP() do { if (STAMP && wid == 0 && nts < 64) { const unsigned long long _c = (unsigned long long)clock64(); \
        ts_lo = (lane == nts) ? (int)(unsigned)_c : ts_lo; ts_hi = (lane == nts) ? (int)(unsigned)(_c >> 32) : ts_hi; ++nts; } } while (0)
    PG8_STAMP();
    unsigned voffA[2], voffB[2];
#pragma unroll
    for (int i = 0; i < 2; ++i) { int R, C; stage_rc(tid * 16 + i * 8192, R, C); const int Rb = Epi::PERM ? ((R & ~31) + perm32(R & 31)) : R;
        voffA[i] = (unsigned)(R * K + C) * 2u; voffB[i] = (unsigned)(Rb * K + C) * 2u; }
    const size_t kstep = (size_t)(BK * 2);
    const size_t hstep = (size_t)HALF * K * 2;
    const size_t tstep = 2 * hstep;
    const unsigned ldsw = (unsigned)wid * 1024u;
    const int aoff = lds_byte(wr * 64 + fr, fq * 8), boff = lds_byte(wc * 32 + fr, fq * 8);
#define PG8_SA(b, h) (((b) * 2 + (h)) * HTB)
#define PG8_SB(b, h) ((4 + (b) * 2 + (h)) * HTB)
#define PG8_STAGE(bufoff, gbase, voff) do { _Pragma("unroll") for (int _i = 0; _i < 2; ++_i) \
        __builtin_amdgcn_global_load_lds((const unsigned*)((const char*)(gbase) + (voff)[_i]), (PG8_LAS unsigned*)(lds + (bufoff) + ldsw + _i * 8192), 16, 0, 0); } while (0)
#define PG8_LDA(dst, b, h) do { _Pragma("unroll") for (int m = 0; m < 4; ++m) _Pragma("unroll") for (int k = 0; k < 2; ++k) dst[m][k] = *(const PG8_LAS bf16x8*)(lds + PG8_SA(b, h) + aoff + m * 2048 + k * 1024); } while (0)
#define PG8_LDB(dst, b, h) do { _Pragma("unroll") for (int n = 0; n < 2; ++n) _Pragma("unroll") for (int k = 0; k < 2; ++k) dst[n][k] = *(const PG8_LAS bf16x8*)(lds + PG8_SB(b, h) + boff + n * 2048 + k * 1024); } while (0)
#define PG8_MMA(ai, bj, At, Bt) do { __builtin_amdgcn_s_setprio(1); _Pragma("unroll") for (int m = 0; m < 4; ++m) _Pragma("unroll") for (int n = 0; n < 2; ++n) _Pragma("unroll") for (int k = 0; k < 2; ++k) \
        acc[ai][bj][m][n] = __builtin_amdgcn_mfma_f32_16x16x32_bf16(Bt[n][k], At[m][k], acc[ai][bj][m][n], 0, 0, 0); __builtin_amdgcn_s_setprio(0); } while (0)
#define PG8_WAIT_V(n) asm volatile("s_waitcnt vmcnt(" #n ")" ::: "memory")
#define PG8_WAIT_L(n) asm volatile("s_waitcnt lgkmcnt(" #n ")" ::: "memory")
#define PG8_BAR __builtin_amdgcn_s_barrier()
#define PG8_SCHED __builtin_amdgcn_sched_barrier(0)
    Unit cur, nxt; int ui = 0;
    if (!S.next(0, cur)) return;
    f32x4 acc[2][2][4][2];
#pragma unroll
    for (int a = 0; a < 2; ++a)
#pragma unroll
        for (int b = 0; b < 2; ++b)
#pragma unroll
            for (int m = 0; m < 4; ++m)
#pragma unroll
                for (int n = 0; n < 2; ++n) acc[a][b][m][n] = (f32x4){0.f, 0.f, 0.f, 0.f};
    bf16x8 At[4][2], B0[2][2], B1[2][2];
    const char* cA = (const char*)g.A + (size_t)cur.pm * tstep; const char* cB = (const char*)g.Bt + (size_t)cur.pn * tstep;
    S.a_ready(cur);
    PG8_STAGE(PG8_SB(0, 0), cB, voffB); PG8_STAGE(PG8_SA(0, 0), cA, voffA); PG8_STAGE(PG8_SB(0, 1), cB + hstep, voffB); PG8_STAGE(PG8_SA(0, 1), cA + hstep, voffA);
    if (wr == 1) PG8_BAR;
    PG8_WAIT_V(4); PG8_BAR;
    PG8_STAGE(PG8_SB(1, 0), cB + kstep, voffB); PG8_STAGE(PG8_SA(1, 0), cA + kstep, voffA); PG8_STAGE(PG8_SB(1, 1), cB + hstep + kstep, voffB);
    PG8_WAIT_V(6); PG8_BAR;
    PG8_STAMP();
    for (;;) {
        const bool has_next = S.next(ui + 1, nxt);
        const char* nA = has_next ? (const char*)g.A + (size_t)nxt.pm * tstep : cA; const char* nB = has_next ? (const char*)g.Bt + (size_t)nxt.pn * tstep : cB;
        for (int t = 0; t < nt; t += 2) {
            const bool last = (t == nt - 2);
            const char* a1 = cA + (size_t)(t + 1) * kstep;
            const char* a2 = last ? nA : cA + (size_t)(t + 2) * kstep; const char* b2 = last ? nB : cB + (size_t)(t + 2) * kstep;
            const char* a3 = a2 + kstep; const char* b3 = b2 + kstep;
            if (last && has_next) S.a_ready(nxt);
            PG8_LDB(B0, 0, 0); PG8_SCHED; PG8_LDA(At, 0, 0); PG8_STAGE(PG8_SA(1, 1), a1 + hstep, voffA);
            PG8_WAIT_L(8); PG8_BAR; PG8_WAIT_L(0); PG8_MMA(0, 0, At, B0); PG8_BAR; PG8_SCHED;
            PG8_LDB(B1, 0, 1); PG8_STAGE(PG8_SB(0, 0), b2, voffB);
            PG8_BAR; PG8_WAIT_L(0); PG8_MMA(0, 1, At, B1); PG8_BAR;
            PG8_LDA(At, 0, 1); PG8_STAGE(PG8_SA(0, 0), a2, voffA);
            PG8_BAR; PG8_WAIT_L(0); PG8_MMA(1, 0, At, B0); PG8_BAR; PG8_SCHED;
            PG8_STAGE(PG8_SB(0, 1), b2 + hstep, voffB);
            PG8_WAIT_V(6); PG8_BAR; PG8_MMA(1, 1, At, B1); PG8_BAR;
            PG8_LDB(B0, 1, 0); PG8_SCHED; PG8_LDA(At, 1, 0); PG8_STAGE(PG8_SA(0, 1), a2 + hstep, voffA);
            PG8_WAIT_L(8); PG8_BAR; PG8_WAIT_L(0); PG8_MMA(0, 0, At, B0); PG8_BAR; PG8_SCHED;
            PG8_LDB(B1, 1, 1); PG8_STAGE(PG8_SB(1, 0), b3, voffB);
            PG8_BAR; PG8_WAIT_L(0); PG8_MMA(0, 1, At, B1); PG8_BAR;
            PG8_LDA(At, 1, 1); PG8_STAGE(PG8_SA(1, 0), a3, voffA);
            PG8_BAR; PG8_WAIT_L(0); PG8_MMA(1, 0, At, B0); PG8_BAR; PG8_SCHED;
            PG8_STAGE(PG8_SB(1, 1), b3 + hstep, voffB);
            PG8_WAIT_V(6); PG8_BAR; PG8_MMA(1, 1, At, B1); PG8_BAR;
        }
        PG8_STAMP();
        if constexpr (!Epi::AFTER_DRAIN) { E(acc, cur, wr, wc, fr, fq, lds, ui); S.done(cur); }
        PG8_STAMP();
        if (!has_next) break;
#pragma unroll
        for (int a = 0; a < 2; ++a)
#pragma unroll
            for (int b = 0; b < 2; ++b)
#pragma unroll
                for (int m = 0; m < 4; ++m)
#pragma unroll
                    for (int n = 0; n < 2; ++n) acc[a][b][m][n] = (f32x4){0.f, 0.f, 0.f, 0.f};
        cur = nxt; cA = nA; cB = nB; ++ui;
    }
    PG8_WAIT_V(0);
    if (wr == 0) PG8_BAR;
    PG8_BAR;
    if constexpr (Epi::AFTER_DRAIN) { E.fused(acc, cur, wr, wc, fr, fq, lds, wid, lane); S.done(cur); }
    PG8_STAMP();
    if (STAMP && wid == 0) { stamps[lane] = lane < nts ? (((unsigned long long)(unsigned)ts_hi << 32) | (unsigned)ts_lo) : 0ull;
        if (lane == 62) stamps[62] = rt_entry; if (lane == 63) stamps[63] = (unsigned long long)wall_clock64(); }
#undef PG8_STAMP
#undef PG8_SA
#undef PG8_SB
#undef PG8_STAGE
#undef PG8_LDA
#undef PG8_LDB
#undef PG8_MMA
#undef PG8_WAIT_V
#undef PG8_WAIT_L
#undef PG8_BAR
#undef PG8_SCHED
}
}

#define LAS __attribute__((address_space(3)))
typedef unsigned short bf16_t;
typedef short bf16x8 __attribute__((ext_vector_type(8)));
typedef float f32x4 __attribute__((ext_vector_type(4)));
typedef unsigned u32x4 __attribute__((ext_vector_type(4)));
typedef unsigned u32x2 __attribute__((ext_vector_type(2)));

constexpr int DM = 1024, NPR = 16384, NSM = 128, MR = 16512, MP = 16640;
constexpr float EPSN = 1e-6f;
constexpr int LDS_BYTES = 159744;
constexpr int NPHASE = 26;

constexpr size_t OFF_YP = 0, OFF_YS = 16777216, OFF_RP = 16908288, OFF_RS = 17694720, OFF_KP = 42860544, OFF_VP = 42991616,
                 OFF_KS = 43122688, OFF_VS = 47316992, OFF_MK = 51511296, OFF_MV = 52559872;
constexpr size_t WS_WINA = 0;
constexpr size_t WS_WOUT = WS_WINA + 2ull * 3328 * 1024 * 2;
constexpr size_t WS_WINB0 = WS_WOUT + 4ull * 1024 * 1024 * 2;
constexpr size_t WS_WINB1 = WS_WINB0 + 1536ull * 1024 * 2;
constexpr size_t WS_WMEM = WS_WINB1 + 1024ull * 1024 * 2;
constexpr size_t WS_WUP = WS_WMEM + 2048ull * 1024 * 2;
constexpr size_t WS_WDOWN = WS_WUP + 4ull * 4096 * 1024 * 2;
constexpr size_t WS_X = WS_WDOWN + 4ull * 4096 * 1024 * 2;
constexpr size_t WS_XB = WS_X + (size_t)MP * 1024 * 4;
constexpr size_t WS_PROJ = WS_XB + (size_t)MP * 1024 * 2;
constexpr size_t WS_O = WS_PROJ + (size_t)MP * 4096 * 2;
constexpr size_t WS_KVS = WS_O + (size_t)MP * 1024 * 2;
constexpr size_t WS_KVC = WS_KVS + (size_t)MP * 512 * 2;
constexpr size_t WS_MEMB = WS_KVC + 768ull * 16384 * 4;
constexpr size_t WS_SS = WS_MEMB + 1024ull * 1024 * 2;
constexpr size_t WS_RSM = WS_SS + 9ull * NPR * 16 * 4;
constexpr size_t WS_MKV = WS_RSM + 4096;
constexpr size_t WS_XSB = WS_MKV + 1024ull * 2048 * 2;
constexpr size_t WS_BAR = WS_XSB + 128ull * 1024 * 2;
constexpr size_t WS_END = WS_BAR + 16384;

struct Job { const float* src; const float* g; bf16_t* dst; int K, N, tstart, pad; };
struct Params {
    const float* in[22];
    float* out;
    unsigned char* ws;
    Job jobs[21];
    int njobs, ntiles, ph_lo, ph_hi;
    int tcut[4];
};


__device__ __forceinline__ int ltid() { int t = threadIdx.x; asm volatile("" : "+v"(t)); return t; }
__device__ __forceinline__ int lbid() { int t = blockIdx.x; asm volatile("" : "+s"(t)); return t; }
__device__ __forceinline__ int lz() { int t = 0; asm volatile("" : "+s"(t)); return t; }
typedef float f32x2_ __attribute__((ext_vector_type(2)));
typedef __bf16 bf16x2_ __attribute__((ext_vector_type(2)));
__device__ __forceinline__ unsigned cvt2(float lo, float hi) { f32x2_ v = {lo, hi}; bf16x2_ b = __builtin_convertvector(v, bf16x2_); return __builtin_bit_cast(unsigned, b); }
__device__ __forceinline__ bf16_t f2bf(float f) { return (bf16_t)(cvt2(f, 0.f) & 0xffffu); }
__device__ __forceinline__ float bf2f(unsigned b) { return __uint_as_float(b << 16); }
__device__ __forceinline__ float bflo(unsigned w) { return __uint_as_float(w << 16); }
__device__ __forceinline__ float bfhi(unsigned w) { return __uint_as_float(w & 0xffff0000u); }
__device__ __forceinline__ bf16x8 ldfrag(const LAS bf16_t* base, int row, int stride, int k) { return *(const LAS bf16x8*)(base + row * stride + k); }
__device__ __forceinline__ f32x4 mfma16(bf16x8 a, bf16x8 b, f32x4 c) { return __builtin_amdgcn_mfma_f32_16x16x32_bf16(a, b, c, 0, 0, 0); }
__device__ __forceinline__ float wave_sum(float v) { for (int o = 32; o >= 1; o >>= 1) v += __shfl_xor(v, o); return v; }
__device__ __forceinline__ float wave_max(float v) { for (int o = 32; o >= 1; o >>= 1) v = fmaxf(v, __shfl_xor(v, o)); return v; }
__device__ __forceinline__ float log_gamma(int h) { return log1pf(-exp2f(-5.0f - (float)h)); }
__device__ __forceinline__ float alibi_slope(int hq) { return hq < 8 ? exp2f(-(float)(hq + 1)) : exp2f(-0.5f - (float)(hq - 8)); }

template <int ACT, int KV> struct EpiProj {
    static constexpr bool PERM = true, AFTER_DRAIN = false;
    bf16_t* O; int ldc; const float* ss; bf16_t* O2; float* outp;
    template <class Sched> __device__ __forceinline__ void prepass(const Sched& S, LAS unsigned char* lds) const {
        const int t = ltid(), r = t & 255, hf = t >> 8;
        f32x4 a[2][4]; bool ok[2];
#pragma unroll
        for (int ps = 0; ps < 2; ++ps) {
            pg8::Unit u; ok[ps] = S.next(ps * 2 + hf, u);
            if (ok[ps]) { const f32x4* sp = (const f32x4*)(ss + (size_t)(u.pm * 256 + r) * 16); a[ps][0] = sp[0]; a[ps][1] = sp[1]; a[ps][2] = sp[2]; a[ps][3] = sp[3]; }
        }
#pragma unroll
        for (int ps = 0; ps < 2; ++ps)
            if (ok[ps]) { const f32x4 s4 = (a[ps][0] + a[ps][1]) + (a[ps][2] + a[ps][3]);
                ((LAS float*)(lds + 131072))[(ps * 2 + hf) * 256 + r] = 1.0f / sqrtf(((s4[0] + s4[1]) + (s4[2] + s4[3])) * (1.0f / 1024.0f) + EPSN); }
        __syncthreads();
    }
    __device__ __forceinline__ void operator()(const f32x4 (&acc)[2][2][4][2], const pg8::Unit& u, int wr, int wc, int fr, int fq, LAS unsigned char* lds, int buf) const {
        const LAS float* rst = (const LAS float*)(lds + 131072) + buf * 256 + wr * 64 + fr;
        const int row0 = u.pm * 256 + wr * 64 + fr; int colt = u.pn * 256; bf16_t* base = O; int ld = ldc; bool kvt = false;
        if (KV && colt >= 1024) { kvt = true; colt -= 1024; base = O2; ld = 512; }
        const int col0 = colt + wc * 32 + 8 * fq;
#pragma unroll
        for (int ai = 0; ai < 2; ++ai)
#pragma unroll
            for (int m = 0; m < 4; ++m) {
                const int row = row0 + ai * 128 + m * 16;
                const float rs = rst[ai * 128 + m * 16];
                bf16_t* rowp = base + (size_t)row * ld + col0;
                float* fo = nullptr;
                if (KV && kvt) {
                    if (row < NPR) { const int pos = row & 4095; if (pos >= 3968) fo = outp + OFF_KP + ((size_t)((row >> 12) * 128 + (pos - 3968))) * 256; }
                }
#pragma unroll
                for (int bj = 0; bj < 2; ++bj) {
                    f32x4 v0 = acc[ai][bj][m][0] * rs, v1 = acc[ai][bj][m][1] * rs;
                    if (ACT == 1) {
#pragma unroll
                        for (int j = 0; j < 4; ++j) { float a = fmaxf(v0[j], 0.f), b = fmaxf(v1[j], 0.f); v0[j] = a * a; v1[j] = b * b; }
                    }
                    u32x4 w; w.x = cvt2(v0[0], v0[1]); w.y = cvt2(v0[2], v0[3]); w.z = cvt2(v1[0], v1[1]); w.w = cvt2(v1[2], v1[3]);
                    *(u32x4*)(rowp + bj * 128) = w;
                    if (KV && fo) {
                        const int c = col0 + bj * 128;
                        float* f = fo + (c >= 256 ? (c - 256) + (OFF_VP - OFF_KP) : c);
                        *(f32x4*)f = v0; *(f32x4*)(f + 4) = v1;
                    }
                }
            }
    }
};
struct EpiResid {
    static constexpr bool PERM = true, AFTER_DRAIN = false;
    bf16_t* Xb; float* ss;
    template <class Sched> __device__ __forceinline__ void prepass(const Sched&, LAS unsigned char*) const {}
    __device__ __forceinline__ void operator()(const f32x4 (&acc)[2][2][4][2], const pg8::Unit& u, int wr, int wc, int fr, int fq, LAS unsigned char*, int) const {
        const int row0 = u.pm * 256 + wr * 64 + fr, col0 = u.pn * 256 + wc * 32 + 8 * fq;
#pragma unroll
        for (int ai = 0; ai < 2; ++ai)
#pragma unroll
            for (int m = 0; m < 4; ++m) {
                const int row = row0 + ai * 128 + m * 16; bf16_t* xp = Xb + (size_t)row * 1024 + col0; float s = 0.f;
                const u32x4 o0 = *(const u32x4*)xp, o1 = *(const u32x4*)(xp + 128);
#pragma unroll
                for (int bj = 0; bj < 2; ++bj) {
                    const u32x4 o = bj ? o1 : o0;
                    const f32x4 a0 = acc[ai][bj][m][0], a1 = acc[ai][bj][m][1];
                    const float x0 = bflo(o.x) + a0[0], x1 = bfhi(o.x) + a0[1], x2 = bflo(o.y) + a0[2], x3 = bfhi(o.y) + a0[3];
                    const float x4 = bflo(o.z) + a1[0], x5 = bfhi(o.z) + a1[1], x6 = bflo(o.w) + a1[2], x7 = bfhi(o.w) + a1[3];
                    u32x4 w; w.x = cvt2(x0, x1); w.y = cvt2(x2, x3); w.z = cvt2(x4, x5); w.w = cvt2(x6, x7);
                    *(u32x4*)(xp + bj * 128) = w;
                    s += ((x0 * x0 + x1 * x1) + (x2 * x2 + x3 * x3)) + ((x4 * x4 + x5 * x5) + (x6 * x6 + x7 * x7));
                }
                s += __shfl_xor(s, 16); s += __shfl_xor(s, 32);
                if (fq == 0) ss[(size_t)row * 16 + u.pn * 4 + wc] = s;
            }
    }
};
struct EpiMemKV {
    static constexpr bool PERM = false, AFTER_DRAIN = false;
    float* outp; const float* rsm; bf16_t* mkv;
    template <class Sched> __device__ __forceinline__ void prepass(const Sched&, LAS unsigned char*) const {}
    __device__ __forceinline__ void operator()(const f32x4 (&acc)[2][2][4][2], const pg8::Unit& u, int wr, int wc, int fr, int fq, LAS unsigned char*, int) const {
        const int row0 = u.pm * 256 + wr * 64 + fr, col0 = u.pn * 256 + wc * 32 + 4 * fq;
#pragma unroll
        for (int ai = 0; ai < 2; ++ai)
#pragma unroll
            for (int m = 0; m < 4; ++m) {
                const int row = row0 + ai * 128 + m * 16; const float rs = rsm[row];
#pragma unroll
                for (int bj = 0; bj < 2; ++bj)
#pragma unroll
                    for (int n = 0; n < 2; ++n) {
                        const int c = col0 + bj * 128 + n * 16, l = c >> 9, kv = (c >> 8) & 1, cc = c & 255;
                        float* dst = outp + (kv ? OFF_MV : OFF_MK) + (size_t)l * (1024 * 256) + (size_t)row * 256 + cc;
                        const f32x4 v = acc[ai][bj][m][n] * rs; *(f32x4*)dst = v;
                        u32x2 w; w.x = cvt2(v[0], v[1]); w.y = cvt2(v[2], v[3]); *(u32x2*)(mkv + (size_t)row * 2048 + c) = w;
                    }
            }
    }
};
template <class Epi> __device__ __forceinline__ void run_gemm(LAS unsigned char* lds, const bf16_t* A, const bf16_t* Bt, int M, int N, int K, const Epi& E, int coff = 0) {
    pg8::Gemm g; g.A = A; g.Bt = Bt; g.M = M; g.N = N; g.K = K;
    const int c_ = lbid() - coff; if (c_ < 0) return;
    pg8::StaticOrder S; S.init(M, N, (int)gridDim.x, c_);
    E.prepass(S, lds);
    pg8::gemm_phase<Epi, pg8::StaticOrder, false>(lds, g, S, E, nullptr);
}

__device__ __forceinline__ void convert_tiles(const Params& p, LAS unsigned char* lds, int lo, int hi, int b0, int nbk) {
    constexpr int SUBS = 4, TS = 512 / SUBS, NL = 1024 / TS, TPR = TS / 64, KSP = 64 / TPR;
    const int tid = ltid(), bid = lbid();
    if (bid < b0) return;
    const int sub = tid / TS, t8 = tid % TS;
    LAS float* tile = (LAS float*)lds + sub * (64 * 65);
    float4 v[NL]; float gk[NL]; bf16_t* dst = nullptr; int K = 0, k0 = 0, n0 = 0;
    auto fetch = [&](int t, float4 (&vv)[NL], float (&gg)[NL], bf16_t*& d, int& KK, int& kk0, int& nn0) {
        int j = 0;
        while (j + 1 < p.njobs && t >= p.jobs[j + 1].tstart) ++j;
        const float* src = p.jobs[j].src; const float* g = p.jobs[j].g; d = p.jobs[j].dst; KK = p.jobs[j].K; const int N = p.jobs[j].N, tl = t - p.jobs[j].tstart;
        const int ntn = N >> 6; kk0 = (tl / ntn) * 64; nn0 = (tl % ntn) * 64;
#pragma unroll
        for (int i = 0; i < NL; ++i) { const int k = (t8 >> 4) + (TS / 16) * i, n4 = (t8 & 15) * 4; vv[i] = *(const float4*)(src + (size_t)(kk0 + k) * N + nn0 + n4); gg[i] = g ? g[kk0 + k] : 1.0f; }
    };
    const int step = SUBS * nbk;
    int t = lo + SUBS * (bid - b0) + sub;
    bool have = t < hi;
    if (have) fetch(t, v, gk, dst, K, k0, n0);
    for (int tb = lo + SUBS * (bid - b0); tb < hi; tb += step) {
        const int tn = t + step; const bool have2 = tn < hi;
        float4 v2[NL]; float g2[NL]; bf16_t* dst2 = nullptr; int K2 = 0, k02 = 0, n02 = 0;
        if (have2) fetch(tn, v2, g2, dst2, K2, k02, n02);
        if (have) {
#pragma unroll
            for (int i = 0; i < NL; ++i) { const int k = (t8 >> 4) + (TS / 16) * i, n4 = (t8 & 15) * 4;
                tile[k * 65 + n4 + 0] = v[i].x * gk[i]; tile[k * 65 + n4 + 1] = v[i].y * gk[i]; tile[k * 65 + n4 + 2] = v[i].z * gk[i]; tile[k * 65 + n4 + 3] = v[i].w * gk[i]; }
        }
        __syncthreads();
        if (have) {
            const int n = t8 / TPR, kb = (t8 % TPR) * KSP;
#pragma unroll
            for (int h2 = 0; h2 < KSP / 8; ++h2) {
                const int k8 = kb + h2 * 8; u32x4 w;
                w.x = cvt2(tile[(k8 + 0) * 65 + n], tile[(k8 + 1) * 65 + n]); w.y = cvt2(tile[(k8 + 2) * 65 + n], tile[(k8 + 3) * 65 + n]);
                w.z = cvt2(tile[(k8 + 4) * 65 + n], tile[(k8 + 5) * 65 + n]); w.w = cvt2(tile[(k8 + 6) * 65 + n], tile[(k8 + 7) * 65 + n]);
                *(u32x4*)(dst + (size_t)(n0 + n) * K + k0 + k8) = w;
            }
        }
        __syncthreads();
#pragma unroll
        for (int i = 0; i < NL; ++i) { v[i] = v2[i]; gk[i] = g2[i]; }
        dst = dst2; K = K2; k0 = k02; n0 = n02; t = tn; have = have2;
    }
}
__device__ __forceinline__ void copy_swa_cache(const Params& p, int part, int b0, int nbk) {
    float* outp_ = p.out; asm volatile("" : "+s"(outp_)); const int z = lz();
    const int tid = ltid(), bid = lbid();
    if (bid < b0) return;
    const int per = 128 * 8128, tot3 = (2 * per) / 3 + 1, lo = part * tot3, hi = (lo + tot3 < 2 * per) ? lo + tot3 : 2 * per, stride = nbk * 512;
    auto srcp = [&](int i) -> const float4* { const int kv = i >= per ? 1 : 0, r = i - kv * per, b = r / 8128, c4 = r - b * 8128; return (const float4*)(p.in[z + 5 + kv] + (size_t)b * 32768 + 256 + c4 * 4); };
    auto dstp = [&](int i) -> float4* { const int kv = i >= per ? 1 : 0, r = i - kv * per, b = r / 8128, c4 = r - b * 8128; return (float4*)(outp_ + (kv ? OFF_VS : OFF_KS) + (size_t)b * 32768 + c4 * 4); };
    int i = lo + (bid - b0) * 512 + tid;
    for (; i + 3 * stride < hi; i += 4 * stride) {
        const float4 a = *srcp(i), b = *srcp(i + stride), c = *srcp(i + 2 * stride), d = *srcp(i + 3 * stride);
        *dstp(i) = a; *dstp(i + stride) = b; *dstp(i + 2 * stride) = c; *dstp(i + 3 * stride) = d;
    }
    for (; i < hi; i += stride) *dstp(i) = *srcp(i);
}
__device__ void phase0(const Params& p, LAS unsigned char* lds) {
    unsigned char* ws = p.ws; float* outp_ = p.out; asm volatile("" : "+s"(ws), "+s"(outp_)); const int z = lz();
    const int tid = ltid(), bid = lbid(), nb = gridDim.x, wid = tid >> 6, lane = tid & 63;
    convert_tiles(p, lds, 0, p.tcut[0], 0, nb);
    float* X = (float*)(ws + WS_X); bf16_t* Xb = (bf16_t*)(ws + WS_XB); float* ss = (float*)(ws + WS_SS);
    bf16_t* memb = (bf16_t*)(ws + WS_MEMB); float* rsm = (float*)(ws + WS_RSM);
    for (int row0 = bid * 8 + wid; row0 < MR + 1024; row0 += nb * 16) {
        float4 v[2][4];
#pragma unroll
        for (int r2 = 0; r2 < 2; ++r2) {
            const int row = row0 + r2 * nb * 8;
            if (row < MR + 1024) {
                const float* src = row < NPR ? p.in[z + 0] + (size_t)row * 1024 : row < MR ? p.in[z + 1] + (size_t)(row - NPR) * 1024 : p.in[z + 7] + (size_t)(row - MR) * 1024;
#pragma unroll
                for (int i = 0; i < 4; ++i) v[r2][i] = *(const float4*)(src + i * 256 + lane * 4);
            }
        }
#pragma unroll
        for (int r2 = 0; r2 < 2; ++r2) {
            const int row = row0 + r2 * nb * 8;
            if (row < MR + 1024) {
                float s = 0.f;
#pragma unroll
                for (int i = 0; i < 4; ++i) {
                    const float4 x = v[r2][i]; const int c = i * 256 + lane * 4;
                    s += x.x * x.x + x.y * x.y + x.z * x.z + x.w * x.w;
                    u32x2 w; w.x = cvt2(x.x, x.y); w.y = cvt2(x.z, x.w);
                    if (row < NPR) *(u32x2*)(Xb + (size_t)row * 1024 + c) = w;
                    else if (row < MR) { *(float4*)(X + (size_t)row * 1024 + c) = x; *(u32x2*)((bf16_t*)(ws + WS_XSB) + (size_t)(row - NPR) * 1024 + c) = w; }
                    else *(u32x2*)(memb + (size_t)(row - MR) * 1024 + c) = w;
                }
                s = wave_sum(s);
                if (row < NPR) { if (lane < 16) ss[(size_t)row * 16 + lane] = lane == 0 ? s : 0.f; } else if (row >= MR && lane == 0) rsm[row - MR] = 1.0f / sqrtf(s * (1.0f / 1024.0f) + EPSN);
            }
        }
    }
}

typedef short s16x4 __attribute__((ext_vector_type(4)));
__device__ __forceinline__ bf16x8 trfrag(const LAS bf16_t* base, int stride, int k0, int c0, int lane) {
    const int g = lane >> 4, q = (lane & 15) >> 2, pp = lane & 3;
    LAS bf16_t* a = (LAS bf16_t*)base + (k0 + 8 * g + q) * stride + c0 + 4 * pp;
    const s16x4 v0 = __builtin_amdgcn_ds_read_tr16_b64_v4i16((LAS s16x4*)a);
    const s16x4 v1 = __builtin_amdgcn_ds_read_tr16_b64_v4i16((LAS s16x4*)(a + 4 * stride));
    return __builtin_shufflevector(v0, v1, 0, 1, 2, 3, 4, 5, 6, 7);
}
constexpr int RS = 144;
__device__ __forceinline__ void ret_kvchunk_items(const Params& p, LAS unsigned char* lds, int it0, int it_end, int stride) {
    unsigned char* ws = p.ws; asm volatile("" : "+s"(ws));
    const int tid = ltid(), wid = tid >> 6, lane = tid & 63, fr = lane & 15, fq = lane >> 4;
    const bf16_t* proj = (const bf16_t*)(ws + WS_PROJ);
    LAS bf16_t* Ks = (LAS bf16_t*)lds; LAS bf16_t* Vs = Ks + 128 * RS;
    auto fetch = [&](int it, u32x4 (&kq)[4], u32x4 (&vq)[4]) {
        const int bh = it >> 5, n = it & 31, b = bh / 6, h = bh % 6, r0 = b * 4096 + n * 128;
#pragma unroll
        for (int i = 0; i < 4; ++i) {
            const int idx = tid + i * 512, tt = idx >> 4, c8 = (idx & 15) * 8;
            const bf16_t* src = proj + (size_t)(r0 + tt) * 3328 + h * 128 + c8;
            kq[i] = *(const u32x4*)(src + 768); vq[i] = *(const u32x4*)(src + 1536);
        }
    };
    u32x4 kq[4], vq[4];
    if (it0 < it_end) fetch(it0, kq, vq);
    for (int it = it0; it < it_end; it += stride) {
        const int h = (it >> 5) % 6;
        const float lg = log_gamma(h);
#pragma unroll
        for (int i = 0; i < 4; ++i) {
            const int idx = tid + i * 512, tt = idx >> 4, c8 = (idx & 15) * 8;
            const float sc = __expf((float)(127 - tt) * lg) * 0.08838834764831845f;
            u32x4 kw; kw.x = cvt2(bflo(kq[i].x) * sc, bfhi(kq[i].x) * sc); kw.y = cvt2(bflo(kq[i].y) * sc, bfhi(kq[i].y) * sc); kw.z = cvt2(bflo(kq[i].z) * sc, bfhi(kq[i].z) * sc); kw.w = cvt2(bflo(kq[i].w) * sc, bfhi(kq[i].w) * sc);
            *(LAS u32x4*)(Ks + tt * RS + c8) = kw; *(LAS u32x4*)(Vs + tt * RS + c8) = vq[i];
        }
        __syncthreads();
        if (it + stride < it_end) fetch(it + stride, kq, vq);
        f32x4 acc[8];
#pragma unroll
        for (int i = 0; i < 8; ++i) acc[i] = (f32x4){0.f, 0.f, 0.f, 0.f};
#pragma unroll
        for (int ks = 0; ks < 4; ++ks) {
            const bf16x8 a = trfrag(Ks, RS, ks * 32, wid * 16, lane);
#pragma unroll
            for (int nt = 0; nt < 8; ++nt) acc[nt] = mfma16(trfrag(Vs, RS, ks * 32, nt * 16, lane), a, acc[nt]);
        }
        bf16_t* dst = (bf16_t*)(ws + WS_KVC) + (size_t)it * 16384 + (wid * 16 + fr) * 128 + 4 * fq;
#pragma unroll
        for (int nt = 0; nt < 8; ++nt) { u32x2 w; w.x = cvt2(acc[nt][0], acc[nt][1]); w.y = cvt2(acc[nt][2], acc[nt][3]); *(u32x2*)(dst + nt * 16) = w; }
        __syncthreads();
    }
}
__device__ __forceinline__ void ret_scan(const Params& p, int l) {
    unsigned char* ws = p.ws; float* outp_ = p.out; asm volatile("" : "+s"(ws), "+s"(outp_));
    bf16_t* kvc = (bf16_t*)(ws + WS_KVC);
    for (int idx = lbid() * 512 + ltid(); idx < 24 * 2048; idx += gridDim.x * 512) {
        const int bh = idx >> 11, c8 = idx & 2047, h = bh % 6;
        const float gc = __expf(128.0f * log_gamma(h));
        bf16_t* base = kvc + (size_t)bh * 32 * 16384 + c8 * 8;
        f32x4 s0 = (f32x4){0.f, 0.f, 0.f, 0.f}, s1 = s0;
#pragma unroll 16
        for (int n = 0; n < 32; ++n) {
            const u32x4 t = *(const u32x4*)(base + (size_t)n * 16384);
            u32x4 w; w.x = cvt2(s0[0], s0[1]); w.y = cvt2(s0[2], s0[3]); w.z = cvt2(s1[0], s1[1]); w.w = cvt2(s1[2], s1[3]);
            *(u32x4*)(base + (size_t)n * 16384) = w;
            s0 = s0 * gc + (f32x4){bflo(t.x), bfhi(t.x), bflo(t.y), bfhi(t.y)}; s1 = s1 * gc + (f32x4){bflo(t.z), bfhi(t.z), bflo(t.w), bfhi(t.w)};
        }
        float* o = outp_ + OFF_RP + ((size_t)(l * 24 + bh)) * 16384 + c8 * 8;
        *(f32x4*)o = s0; *(f32x4*)(o + 4) = s1;
    }
}
struct RetPre { bf16x8 a[4]; u32x4 kq[4], vq[4], sq[4]; u32x2 gw[8]; };
__device__ __forceinline__ void ret_out_items(const Params& p, LAS unsigned char* lds, int it0, int it_end, int stride) {
    unsigned char* ws = p.ws; asm volatile("" : "+s"(ws));
    const int tid = ltid(), wid = __builtin_amdgcn_readfirstlane(tid >> 6), lane = tid & 63, fr = lane & 15, fq = lane >> 4;
    const bf16_t* proj = (const bf16_t*)(ws + WS_PROJ);
    LAS bf16_t* Ks = (LAS bf16_t*)lds; LAS bf16_t* Vs = Ks + 128 * RS; LAS bf16_t* Ss = Vs + 128 * RS; LAS bf16_t* Ps = Ss + 128 * RS;
    const int q = wid * 16 + fr;
    auto fetch = [&](int it, RetPre& r) {
        const int bh = it >> 5, n = it & 31, b = bh / 6, h = bh % 6, r0 = b * 4096 + n * 128;
        const bf16_t* sprev = (const bf16_t*)(ws + WS_KVC) + (size_t)it * 16384;
#pragma unroll
        for (int ks = 0; ks < 4; ++ks) r.a[ks] = *(const bf16x8*)(proj + (size_t)(r0 + q) * 3328 + h * 128 + ks * 32 + fq * 8);
#pragma unroll
        for (int i = 0; i < 4; ++i) {
            const int idx = tid + i * 512, tt = idx >> 4, c8 = (idx & 15) * 8;
            const bf16_t* src = proj + (size_t)(r0 + tt) * 3328 + h * 128 + c8;
            r.kq[i] = *(const u32x4*)(src + 768); r.vq[i] = *(const u32x4*)(src + 1536); r.sq[i] = *(const u32x4*)(sprev + tt * 128 + c8);
        }
#pragma unroll
        for (int nt = 0; nt < 8; ++nt) r.gw[nt] = *(const u32x2*)(proj + (size_t)(r0 + q) * 3328 + 2304 + h * 128 + nt * 16 + 4 * fq);
    };
    RetPre cur;
    if (it0 < it_end) fetch(it0, cur);
    for (int it = it0; it < it_end; it += stride) {
        const int bh = it >> 5, n = it & 31, b = bh / 6, h = bh % 6, r0 = b * 4096 + n * 128;
        const float lg = log_gamma(h);
#pragma unroll
        for (int i = 0; i < 4; ++i) {
            const int idx = tid + i * 512, tt = idx >> 4, c8 = (idx & 15) * 8;
            *(LAS u32x4*)(Ks + tt * RS + c8) = cur.kq[i]; *(LAS u32x4*)(Vs + tt * RS + c8) = cur.vq[i]; *(LAS u32x4*)(Ss + tt * RS + c8) = cur.sq[i];
        }
        __syncthreads();
        RetPre nxt = cur;
        if (it + stride < it_end) fetch(it + stride, nxt);
        f32x4 acc[8];
    #pragma unroll
        for (int i = 0; i < 8; ++i) acc[i] = (f32x4){0.f, 0.f, 0.f, 0.f};
    #pragma unroll
        for (int ks = 0; ks < 4; ++ks) {
    #pragma unroll
            for (int nt = 0; nt < 8; ++nt) acc[nt] = mfma16(trfrag(Ss, RS, ks * 32, nt * 16, lane), cur.a[ks], acc[nt]);
            __builtin_amdgcn_sched_barrier(0);
        }
        const float wq = __expf((float)(q + 1) * lg);
    #pragma unroll
        for (int i = 0; i < 8; ++i) acc[i] *= wq;
    #pragma unroll
        for (int nt = 0; nt < 8; ++nt) {
            u32x2 w = (u32x2){0u, 0u};
            if (nt <= wid) {
                f32x4 sc = (f32x4){0.f, 0.f, 0.f, 0.f};
    #pragma unroll
                for (int ks = 0; ks < 4; ++ks) sc = mfma16(ldfrag(Ks, nt * 16 + fr, RS, ks * 32 + fq * 8), cur.a[ks], sc);
                float pv[4];
    #pragma unroll
                for (int j = 0; j < 4; ++j) { const int diff = q - (nt * 16 + 4 * fq + j); pv[j] = diff >= 0 ? sc[j] * 0.08838834764831845f * __expf((float)diff * lg) : 0.f; }
                w.x = cvt2(pv[0], pv[1]); w.y = cvt2(pv[2], pv[3]);
            }
            *(LAS u32x2*)(Ps + q * RS + nt * 16 + 4 * fq) = w;
        }
        asm volatile("s_waitcnt lgkmcnt(0)" ::: "memory");
        __builtin_amdgcn_wave_barrier();
        for (int ks = 0; ks <= (wid >> 1); ++ks) {
            const bf16x8 pa = ldfrag(Ps, q, RS, ks * 32 + fq * 8);
    #pragma unroll
            for (int nt = 0; nt < 8; ++nt) acc[nt] = mfma16(trfrag(Vs, RS, ks * 32, nt * 16, lane), pa, acc[nt]);
        }
        float s = 0.f;
    #pragma unroll
        for (int i = 0; i < 8; ++i) s += (acc[i][0] + acc[i][1]) + (acc[i][2] + acc[i][3]);
        s += __shfl_xor(s, 16); s += __shfl_xor(s, 32);
        const float mu = s * (1.0f / 128.0f);
        float v = 0.f;
    #pragma unroll
        for (int i = 0; i < 8; ++i) { const f32x4 d = acc[i] - mu; v += (d[0] * d[0] + d[1] * d[1]) + (d[2] * d[2] + d[3] * d[3]); }
        v += __shfl_xor(v, 16); v += __shfl_xor(v, 32);
        const float rstd = 1.0f / sqrtf(v * (1.0f / 128.0f) + EPSN);
        bf16_t* op = (bf16_t*)(ws + WS_O) + (size_t)(r0 + q) * 1024 + h * 128 + 4 * fq;
    #pragma unroll
        for (int nt = 0; nt < 8; ++nt) {
            const float g0 = bflo(cur.gw[nt].x), g1 = bfhi(cur.gw[nt].x), g2 = bflo(cur.gw[nt].y), g3 = bfhi(cur.gw[nt].y);
            const float o0 = (acc[nt][0] - mu) * rstd * (g0 * __builtin_amdgcn_rcpf(1.0f + __expf(-g0))), o1 = (acc[nt][1] - mu) * rstd * (g1 * __builtin_amdgcn_rcpf(1.0f + __expf(-g1)));
            const float o2 = (acc[nt][2] - mu) * rstd * (g2 * __builtin_amdgcn_rcpf(1.0f + __expf(-g2))), o3 = (acc[nt][3] - mu) * rstd * (g3 * __builtin_amdgcn_rcpf(1.0f + __expf(-g3)));
            u32x2 w; w.x = cvt2(o0, o1); w.y = cvt2(o2, o3);
            *(u32x2*)(op + nt * 16) = w;
        }
        __syncthreads();
        cur = nxt;
    }
}

constexpr int KS_ = 72, PS_ = 264;
struct KVRegs { u32x4 kq[4], vq[4]; bf16x8 a0, a1; };
struct AttnArgs { const bf16_t* Kb; int ldb, kv0; const bf16_t* Q0; int ldq; size_t qstep; bf16_t* O0; size_t ostep; int T, hq0; const float* sinks; };
__device__ __forceinline__ void attn_fetch(const AttnArgs& A, KVRegs& r) {
    const int tid = ltid(), wid = tid >> 6, lane = tid & 63, fr = lane & 15, fq = lane >> 4, q = wid * 16 + fr;
    r.a0 = *(const bf16x8*)(A.Q0 + (size_t)q * A.ldq + fq * 8); r.a1 = *(const bf16x8*)(A.Q0 + (size_t)q * A.ldq + 32 + fq * 8);
#pragma unroll
    for (int i = 0; i < 4; ++i) {
        const int idx = tid + i * 512, rr = idx >> 3, c8 = (idx & 7) * 8;
        r.kq[i] = (u32x4){0u, 0u, 0u, 0u}; r.vq[i] = (u32x4){0u, 0u, 0u, 0u};
        if (rr >= A.kv0) { r.kq[i] = *(const u32x4*)(A.Kb + (ptrdiff_t)rr * A.ldb + c8); r.vq[i] = *(const u32x4*)(A.Kb + 256 + (ptrdiff_t)rr * A.ldb + c8); }
    }
}
template <int SWA>
__device__ __forceinline__ void attn_group(LAS unsigned char* lds, const AttnArgs& A, const KVRegs& cur, const AttnArgs* nxtA, KVRegs& nxt) {
    const bf16_t* Q0 = A.Q0; const int ldq = A.ldq, kv0 = A.kv0, T = A.T, hq0 = A.hq0; const size_t qstep = A.qstep, ostep = A.ostep; bf16_t* O0 = A.O0; const float* sinks = A.sinks;
    const int tid = ltid(), wid = __builtin_amdgcn_readfirstlane(tid >> 6), lane = tid & 63, fr = lane & 15, fq = lane >> 4;
    LAS bf16_t* Ks = (LAS bf16_t*)lds; LAS bf16_t* Vs = Ks + 256 * KS_; LAS bf16_t* Ps = Vs + 256 * KS_;
    const int q = wid * 16 + fr;
    bf16x8 a0 = cur.a0, a1 = cur.a1;
#pragma unroll
    for (int i = 0; i < 4; ++i) {
        const int idx = tid + i * 512, r = idx >> 3, c8 = (idx & 7) * 8;
        *(LAS u32x4*)(Ks + r * KS_ + c8) = cur.kq[i]; *(LAS u32x4*)(Vs + r * KS_ + c8) = cur.vq[i];
    }
    __syncthreads();
    if (nxtA) attn_fetch(*nxtA, nxt);
    constexpr int NTL = SWA ? 9 : 16, NKS = SWA ? 5 : 8;
    const int nt0 = SWA ? wid : 0, ks0 = SWA ? (wid >> 1) : 0;
    for (int t = 0; t < T; ++t) {
        bf16x8 n0 = a0, n1 = a1;
        if (t + 1 < T) { const bf16_t* qn = Q0 + (size_t)(t + 1) * qstep + (size_t)q * ldq; n0 = *(const bf16x8*)(qn + fq * 8); n1 = *(const bf16x8*)(qn + 32 + fq * 8); }
        const float slope = SWA ? alibi_slope(hq0 + t) * 1.4426950408889634f : 0.f, sink = SWA ? sinks[hq0 + t] * 1.4426950408889634f : 0.f;
        int frl = fr; asm volatile("" : "+v"(frl));
        const float tb = -slope * (float)(128 + frl - 4 * fq);
        f32x4 sc[NTL];
        float mx = SWA ? sink : -INFINITY;
#pragma unroll
        for (int i = 0; i < NTL; ++i) {
            const int nt = nt0 + i;
            f32x4 s = (f32x4){0.f, 0.f, 0.f, 0.f};
            __builtin_amdgcn_s_setprio(1);
            s = mfma16(ldfrag(Ks, nt * 16 + fr, KS_, fq * 8), a0, s);
            s = mfma16(ldfrag(Ks, nt * 16 + fr, KS_, 32 + fq * 8), a1, s);
            __builtin_amdgcn_s_setprio(0);
            const bool tile_ok = !SWA || (nt * 16 >= kv0);
#pragma unroll
            for (int j = 0; j < 4; ++j) {
                float v;
                if (SWA) {
                    v = fmaf(s[j], 0.125f * 1.4426950408889634f, fmaf(slope, (float)(16 * i + j), tb));
                    bool ok = tile_ok;
                    if (i == 0) ok = ok && (4 * fq + j >= frl);
                    if (i == 8) ok = ok && (4 * fq + j <= frl);
                    v = ok ? v : -INFINITY;
                } else v = s[j] * (0.125f * 1.4426950408889634f);
                s[j] = v; mx = fmaxf(mx, v);
            }
            sc[i] = s;
            if ((i & 3) == 3) __builtin_amdgcn_sched_barrier(0);
        }
        mx = fmaxf(mx, __shfl_xor(mx, 16)); mx = fmaxf(mx, __shfl_xor(mx, 32));
        float sum = 0.f;
#pragma unroll
        for (int i = 0; i < NTL; ++i)
#pragma unroll
            for (int j = 0; j < 4; ++j) { const float e = __builtin_amdgcn_exp2f(sc[i][j] - mx); sc[i][j] = e; sum += e; }
        sum += __shfl_xor(sum, 16); sum += __shfl_xor(sum, 32);
        if (SWA) sum += __builtin_amdgcn_exp2f(sink - mx);
        const float inv = __builtin_amdgcn_rcpf(sum);
        asm volatile("" ::: "memory");
#pragma unroll
        for (int i = 0; i < NTL; ++i) { const f32x4 e = sc[i]; u32x2 w; w.x = cvt2(e[0], e[1]); w.y = cvt2(e[2], e[3]); *(LAS u32x2*)(Ps + q * PS_ + (nt0 + i) * 16 + 4 * fq) = w; }
        if (SWA) { const int zt = (wid & 1) ? wid - 1 : wid + 9; *(LAS u32x2*)(Ps + q * PS_ + zt * 16 + 4 * fq) = (u32x2){0u, 0u}; }
        asm volatile("s_waitcnt lgkmcnt(0)" ::: "memory");
        __builtin_amdgcn_wave_barrier();
        f32x4 acc[4];
#pragma unroll
        for (int i = 0; i < 4; ++i) acc[i] = (f32x4){0.f, 0.f, 0.f, 0.f};
#pragma unroll
        for (int i = 0; i < NKS; ++i) {
            const int ks = ks0 + i;
            const bf16x8 pa = ldfrag(Ps, q, PS_, ks * 32 + fq * 8);
            __builtin_amdgcn_s_setprio(1);
#pragma unroll
            for (int nt = 0; nt < 4; ++nt) acc[nt] = mfma16(trfrag(Vs, KS_, ks * 32, nt * 16, lane), pa, acc[nt]);
            __builtin_amdgcn_s_setprio(0);
            if (i & 1) __builtin_amdgcn_sched_barrier(0);
        }
        bf16_t* O = O0 + (size_t)t * ostep;
#pragma unroll
        for (int nt = 0; nt < 4; ++nt) { const f32x4 o = acc[nt] * inv; u32x2 w; w.x = cvt2(o[0], o[1]); w.y = cvt2(o[2], o[3]); *(u32x2*)(O + (size_t)q * 1024 + nt * 16 + 4 * fq) = w; }
        asm volatile("" ::: "memory");
        a0 = n0; a1 = n1;
    }
    __syncthreads();
}
__device__ __forceinline__ AttnArgs mem_attn_args(const Params& p, int l, int grp, int ldq, int qoff) {
    unsigned char* ws = p.ws; asm volatile("" : "+s"(ws));
    const int tp = grp & 15, h = (grp >> 4) & 3, b = grp >> 6;
    AttnArgs A;
    A.Q0 = (const bf16_t*)(ws + WS_PROJ) + (size_t)(b * 4096 + tp * 256) * ldq + qoff + h * 64;
    A.Kb = (const bf16_t*)(ws + WS_MKV) + (size_t)(b * 256) * 2048 + l * 512 + h * 64; A.ldb = 2048; A.kv0 = 0; A.ldq = ldq; A.qstep = (size_t)128 * ldq;
    A.O0 = (bf16_t*)(ws + WS_O) + (size_t)(b * 4096 + tp * 256) * 1024 + 768 + h * 64; A.ostep = (size_t)128 * 1024; A.T = 2; A.hq0 = 0; A.sinks = nullptr;
    return A;
}
__device__ __forceinline__ AttnArgs swa_args(const Params& p, int j, int grp, int ldq) {
    unsigned char* ws = p.ws; asm volatile("" : "+s"(ws)); const int z = lz();
    const int g = grp & 3, nbk = (grp >> 2) & 31, b = grp >> 7;
    AttnArgs A;
    A.Q0 = (const bf16_t*)(ws + WS_PROJ) + (size_t)(b * 4096 + nbk * 128) * ldq + g * 192;
    A.Kb = (const bf16_t*)(ws + WS_KVS) + ((ptrdiff_t)(b * 4096 + nbk * 128 - 128)) * 512 + g * 64; A.ldb = 512; A.kv0 = nbk == 0 ? 128 : 0; A.ldq = ldq; A.qstep = 64;
    A.O0 = (bf16_t*)(ws + WS_O) + (size_t)(b * 4096 + nbk * 128) * 1024 + g * 192; A.ostep = 64; A.T = 3; A.hq0 = g * 3; A.sinks = p.in[z + 13] + j * 12;
    return A;
}

__device__ float block_max(LAS float* red, float v) {
    v = wave_max(v); __syncthreads(); if ((threadIdx.x & 63) == 0) red[threadIdx.x >> 6] = v; __syncthreads();
    float r = red[0];
#pragma unroll
    for (int i = 1; i < 8; ++i) r = fmaxf(r, red[i]);
    return r;
}
__device__ float block_sum(LAS float* red, float v) {
    v = wave_sum(v); __syncthreads(); if ((threadIdx.x & 63) == 0) red[threadIdx.x >> 6] = v; __syncthreads();
    float r = 0.f;
#pragma unroll
    for (int i = 0; i < 8; ++i) r += red[i];
    return r;
}
template <int SWA>
__device__ __forceinline__ void decode_quad(const Params& p, LAS unsigned char* lds, int l, int j, int qd, int n_items, int ldq, int qoff_mem) {
    constexpr int NK = SWA ? 128 : 256, NTOT = NK + SWA;
    unsigned char* ws = p.ws; asm volatile("" : "+s"(ws)); const int z = lz();
    const int tid = ltid(), sg = tid >> 7, t = tid & 127, lane = tid & 63, w2 = (tid >> 6) & 1;
    const int it = qd * 4 + sg; const bool active = it < n_items; const int itc = active ? it : 0;
    const bf16_t* q; const float* K; const float* V; const bf16_t* kx = nullptr; bf16_t* out; float slope = 0.f, sink = 0.f;
    if (SWA) {
        const int hq = itc % 12, b = itc / 12, g = hq / 3;
        q = (const bf16_t*)(ws + WS_PROJ) + (size_t)(NPR + b) * ldq + hq * 64;
        K = p.in[z + 5] + ((size_t)b * 128) * 256 + g * 64; V = p.in[z + 6] + ((size_t)b * 128) * 256 + g * 64;
        kx = (const bf16_t*)(ws + WS_KVS) + (size_t)(NPR + b) * 512 + g * 64;
        slope = alibi_slope(hq); sink = p.in[z + 13][j * 12 + hq];
        out = (bf16_t*)(ws + WS_O) + (size_t)(NPR + b) * 1024 + hq * 64;
    } else {
        const int h = itc & 3, b = itc >> 2;
        q = (const bf16_t*)(ws + WS_PROJ) + (size_t)(NPR + b) * ldq + qoff_mem + h * 64;
        const size_t base = ((size_t)(l * 128 + b) * 256) * 256 + h * 64;
        K = p.in[z + 2] + base; V = p.in[z + 3] + base;
        out = (bf16_t*)(ws + WS_O) + (size_t)(NPR + b) * 1024 + 768 + h * 64;
    }
    LAS float* base = (LAS float*)lds + sg * 1024; LAS float* qs = base; LAS float* sc = base + 64; LAS float* part = base + 336; LAS float* red = base + 848;
    if (active && t < 64) qs[t] = bf2f(q[t]);
    __syncthreads();
    const int d4 = (t & 15) * 4, mg = t >> 4;
    constexpr int NVE = 16;
    f32x4 vv[NVE];
    if (active) {
        const int sub = t & 3, kr = t >> 2;
        f32x4 qv[4];
#pragma unroll
        for (int i = 0; i < 4; ++i) qv[i] = *(const LAS f32x4*)(qs + sub * 16 + i * 4);
        float sd[NK / 32];
#pragma unroll
        for (int pp = 0; pp < NK / 32; ++pp) {
            const float* kp = K + (size_t)(pp * 32 + kr) * 256 + sub * 16; float a = 0.f;
#pragma unroll
            for (int i = 0; i < 4; ++i) { const f32x4 kv = *(const f32x4*)(kp + i * 4); a += (kv[0] * qv[i][0] + kv[1] * qv[i][1]) + (kv[2] * qv[i][2] + kv[3] * qv[i][3]); }
            sd[pp] = a;
            if ((pp & 3) == 3) __builtin_amdgcn_sched_barrier(0);
        }
#pragma unroll
        for (int i = 0; i < NVE; ++i) vv[i] = *(const f32x4*)(V + (size_t)(mg + 8 * i) * 256 + d4);
#pragma unroll
        for (int pp = 0; pp < NK / 32; ++pp) {
            float a = sd[pp]; a += __shfl_xor(a, 1); a += __shfl_xor(a, 2);
            if (sub == 0) { float v = a * 0.125f; if (SWA) v -= slope * (float)(NK - (pp * 32 + kr)); sc[pp * 32 + kr] = v; }
        }
        if (SWA && w2 == 0) { const float v = wave_sum(qs[lane] * bf2f(kx[lane])); if (lane == 0) sc[NK] = v * 0.125f; }
    }
    __syncthreads();
    const float v0 = (active && t < NTOT) ? sc[t] : -INFINITY, v1 = (active && t + 128 < NTOT) ? sc[t + 128] : -INFINITY;
    { const float m = wave_max(fmaxf(v0, v1)); if (lane == 0) red[w2] = m; }
    __syncthreads();
    float mx = fmaxf(red[0], red[1]); if (SWA) mx = fmaxf(mx, sink);
    const float e0 = (active && t < NTOT) ? __expf(v0 - mx) : 0.f, e1 = (active && t + 128 < NTOT) ? __expf(v1 - mx) : 0.f;
    if (active && t < NTOT) sc[t] = e0;
    if (active && t + 128 < NTOT) sc[t + 128] = e1;
    { const float sm = wave_sum(e0 + e1); if (lane == 0) red[2 + w2] = sm; }
    __syncthreads();
    float sum = red[2] + red[3]; if (SWA) sum += __expf(sink - mx);
    if (active) {
        f32x4 acc = (f32x4){0.f, 0.f, 0.f, 0.f};
#pragma unroll
        for (int i = 0; i < NVE; ++i) acc += vv[i] * sc[mg + 8 * i];
#pragma unroll
        for (int i = NVE; i < NK / 8; ++i) acc += *(const f32x4*)(V + (size_t)(mg + 8 * i) * 256 + d4) * sc[mg + 8 * i];
        if (SWA && mg == 0) { const float pe = sc[NK]; const bf16_t* vx = kx + 256; acc[0] += pe * bf2f(vx[d4]); acc[1] += pe * bf2f(vx[d4 + 1]); acc[2] += pe * bf2f(vx[d4 + 2]); acc[3] += pe * bf2f(vx[d4 + 3]); }
        *(LAS f32x4*)(part + mg * 64 + d4) = acc;
    }
    __syncthreads();
    if (active && t < 64) { float sa = 0.f;
#pragma unroll
        for (int i = 0; i < 8; ++i) sa += part[i * 64 + t];
        out[t] = f2bf(sa / sum); }
    __syncthreads();
}
__device__ __forceinline__ void ret_decode_items(const Params& p, LAS unsigned char* lds, int l, int it0, int it_end, int stride) {
    unsigned char* ws = p.ws; float* outp_ = p.out; asm volatile("" : "+s"(ws), "+s"(outp_)); const int z = lz();
    const int tid = ltid(), lane = tid & 63, e4 = (tid & 31) * 4, dg = tid >> 5, w = tid >> 7, e = tid & 127;
    LAS float* qs = (LAS float*)lds; LAS float* ks = qs + 128; LAS float* vs = ks + 128; LAS float* gs = vs + 128; LAS float* part = gs + 128; LAS float* red = part + 2048;
    auto fetch = [&](int it, f32x4 (&S)[8], float& pv) {
        const int h = it % 6, b = it / 6;
        const float* S0 = p.in[z + 4] + ((size_t)((l * 128 + b) * 6 + h)) * 16384;
#pragma unroll
        for (int i = 0; i < 8; ++i) S[i] = *(const f32x4*)(S0 + (dg + 16 * i) * 128 + e4);
        pv = bf2f(((const bf16_t*)(ws + WS_PROJ))[(size_t)(NPR + b) * 3328 + h * 128 + w * 768 + e]);
    };
    f32x4 S[8]; float pv = 0.f;
    if (it0 < it_end) fetch(it0, S, pv);
    for (int it = it0; it < it_end; it += stride) {
        const int h = it % 6, b = it / 6;
        const float gamma = 1.0f - exp2f(-5.0f - (float)h);
        (w == 0 ? qs : w == 1 ? ks : w == 2 ? vs : gs)[e] = (w == 1) ? pv * 0.08838834764831845f : pv;
        __syncthreads();
        f32x4 Sn[8]; float pvn = 0.f;
#pragma unroll
        for (int i = 0; i < 8; ++i) Sn[i] = S[i];
        if (it + stride < it_end) fetch(it + stride, Sn, pvn);
        float* S1 = outp_ + OFF_RS + ((size_t)((l * 128 + b) * 6 + h)) * 16384;
        const f32x4 vv = (f32x4){vs[e4], vs[e4 + 1], vs[e4 + 2], vs[e4 + 3]};
        f32x4 o = (f32x4){0.f, 0.f, 0.f, 0.f};
#pragma unroll
        for (int i = 0; i < 8; ++i) { const int d = dg + 16 * i; const f32x4 sn = S[i] * gamma + vv * ks[d]; *(f32x4*)(S1 + d * 128 + e4) = sn; o += sn * qs[d]; }
        *(LAS f32x4*)(part + dg * 128 + e4) = o;
        __syncthreads();
        float sv = 0.f;
        if (tid < 128) {
#pragma unroll
            for (int i = 0; i < 16; ++i) sv += part[i * 128 + tid];
            const float s1 = wave_sum(sv), s2 = wave_sum(sv * sv);
            if (lane == 0) { red[2 * (tid >> 6)] = s1; red[2 * (tid >> 6) + 1] = s2; }
        }
        __syncthreads();
        if (tid < 128) {
            const float mu = (red[0] + red[2]) * (1.0f / 128.0f), var = fmaxf((red[1] + red[3]) * (1.0f / 128.0f) - mu * mu, 0.f);
            const float g = gs[tid];
            ((bf16_t*)(ws + WS_O))[(size_t)(NPR + b) * 1024 + h * 128 + tid] = f2bf((sv - mu) / sqrtf(var + EPSN) * (g * __builtin_amdgcn_rcpf(1.0f + __expf(-g))));
        }
        __syncthreads();
#pragma unroll
        for (int i = 0; i < 8; ++i) S[i] = Sn[i];
        pv = pvn;
    }
}


template <int AMODE, int EMODE, int KS, int NT>
__device__ __forceinline__ void skinny_gemm(const Params& p, LAS unsigned char* lds, const bf16_t* Aptr, int lda, const bf16_t* Wt, int N, int K, bf16_t* Ob, int ldo) {
    unsigned char* ws = p.ws; float* outp_ = p.out; asm volatile("" : "+s"(ws), "+s"(outp_));
    const int tid = ltid(), wid = tid >> 6, lane = tid & 63, fr = lane & 15, fq = lane >> 4, bid = lbid();
    const int nunits = 8 * (N / (16 * NT)) * KS, kslice = K / KS;
    LAS float* red = (LAS float*)lds;
    constexpr int RW = 4 * NT + 1;
    for (int u = bid * 8 + wid; u < nunits; u += (int)gridDim.x * 8) {
        const int ks = u % KS, mt = (u / KS) & 7, ng = u / (KS * 8), m0 = mt * 16, n0 = ng * 16 * NT, kb = ks * kslice;
        f32x4 acc[NT]; float ssq = 0.f;
#pragma unroll
        for (int i = 0; i < NT; ++i) acc[i] = (f32x4){0.f, 0.f, 0.f, 0.f};
        const bf16_t* wp = Wt + (size_t)(n0 + fr) * K + kb + fq * 8;
        const bf16_t* ap = Aptr + (size_t)(m0 + fr) * lda + kb + fq * 8;
        f32x4 xold[NT];
        if (EMODE == 2 && ks == 0) {
#pragma unroll
            for (int i = 0; i < NT; ++i) xold[i] = *(const f32x4*)((const float*)(ws + WS_X) + (size_t)(NPR + m0 + fr) * 1024 + n0 + i * 16 + 4 * fq);
        }
#pragma unroll 8
        for (int k = 0; k < kslice; k += 32) {
            const u32x4 aw = *(const u32x4*)(ap + k);
            if (AMODE == 0) {
                const float x0 = bflo(aw.x), x1 = bfhi(aw.x), x2 = bflo(aw.y), x3 = bfhi(aw.y), x4 = bflo(aw.z), x5 = bfhi(aw.z), x6 = bflo(aw.w), x7 = bfhi(aw.w);
                ssq += ((x0 * x0 + x1 * x1) + (x2 * x2 + x3 * x3)) + ((x4 * x4 + x5 * x5) + (x6 * x6 + x7 * x7));
            }
#pragma unroll
            for (int i = 0; i < NT; ++i) acc[i] = mfma16(*(const bf16x8*)(wp + (size_t)i * 16 * K + k), __builtin_bit_cast(bf16x8, aw), acc[i]);
        }
        if (KS > 1) {
            __syncthreads();
            LAS float* r = red + (wid * 64 + lane) * RW;
#pragma unroll
            for (int i = 0; i < NT; ++i) { r[4 * i] = acc[i][0]; r[4 * i + 1] = acc[i][1]; r[4 * i + 2] = acc[i][2]; r[4 * i + 3] = acc[i][3]; }
            r[4 * NT] = ssq;
            __syncthreads();
            if (ks == 0) {
#pragma unroll
                for (int j = 1; j < KS; ++j) { const LAS float* o = red + ((wid + j) * 64 + lane) * RW;
#pragma unroll
                    for (int i = 0; i < NT; ++i) { acc[i][0] += o[4 * i]; acc[i][1] += o[4 * i + 1]; acc[i][2] += o[4 * i + 2]; acc[i][3] += o[4 * i + 3]; }
                    ssq += o[4 * NT]; }
            }
        }
        if (ks == 0) {
            float rs = 1.0f;
            if (AMODE == 0) { ssq += __shfl_xor(ssq, 16); ssq += __shfl_xor(ssq, 32); rs = 1.0f / sqrtf(ssq * (1.0f / 1024.0f) + EPSN); }
            const int row = m0 + fr;
#pragma unroll
            for (int i = 0; i < NT; ++i) {
                const int col = n0 + i * 16 + 4 * fq;
                if (EMODE == 2) {
                    float* xp = (float*)(ws + WS_X) + (size_t)(NPR + row) * 1024 + col; const f32x4 x = xold[i] + acc[i]; *(f32x4*)xp = x;
                    u32x2 w; w.x = cvt2(x[0], x[1]); w.y = cvt2(x[2], x[3]); *(u32x2*)((bf16_t*)(ws + WS_XSB) + (size_t)row * 1024 + col) = w;
                } else {
                    f32x4 v = acc[i] * rs;
                    if (EMODE == 1) {
#pragma unroll
                        for (int j = 0; j < 4; ++j) { const float a = fmaxf(v[j], 0.f); v[j] = a * a; }
                    }
                    u32x2 w; w.x = cvt2(v[0], v[1]); w.y = cvt2(v[2], v[3]);
                    if (EMODE == 3 && col >= 1024) {
                        const int c = col - 1024;
                        *(u32x2*)((bf16_t*)(ws + WS_KVS) + (size_t)(NPR + row) * 512 + c) = w;
                        *(f32x4*)(outp_ + (c >= 256 ? OFF_VS : OFF_KS) + ((size_t)(row * 128 + 127)) * 256 + (c & 255)) = v;
                    } else *(u32x2*)(Ob + (size_t)(NPR + row) * ldo + col) = w;
                }
            }
        }
    }
    if (KS > 1) __syncthreads();
}

__device__ __forceinline__ void warm_weights(LAS unsigned char* lds, const bf16_t* W, int bytes_total) {
    const int tid = ltid(), wid = __builtin_amdgcn_readfirstlane(tid >> 6), lane = tid & 63, bid = lbid();
    const int per = bytes_total >> 8;
    const char* base = (const char*)W + (size_t)bid * per;
    for (int off = wid * 1024; off < per; off += 8192)
        __builtin_amdgcn_global_load_lds((const unsigned*)(base + off + lane * 16), (LAS unsigned*)(lds + 139264 + wid * 1024), 16, 0, 0);
}

#define XB_TMO      128
#define XB_XCNT(j)  (256  + 64 * (j))
#define XB_XSUB(j)  (1280 + 64 * (j))
#define XB_XGEN(j)  (2304 + 64 * (j))
#define XB_TOP      3328
#define XB_TOPGEN   3392
#define XCD_BAR_WORDS 3456
#define XB_SPIN_CAP (1u << 18)
__device__ __forceinline__ unsigned xb_ld(unsigned* p)              { return __hip_atomic_load(p, __ATOMIC_RELAXED, __HIP_MEMORY_SCOPE_AGENT); }
__device__ __forceinline__ unsigned xb_add(unsigned* p, unsigned v) { return __hip_atomic_fetch_add(p, v, __ATOMIC_RELAXED, __HIP_MEMORY_SCOPE_AGENT); }
__device__ __forceinline__ unsigned xb_xcc_id() { return (unsigned)__builtin_amdgcn_s_getreg((3 << 11) | 20) & 0xFu; }
#define XB_SPIN(cond, bar) do { unsigned _sp = 0; while (cond) { __builtin_amdgcn_s_sleep(1); \
    if ((++_sp & 255u) == 0u) { if (xb_ld(&(bar)[XB_TMO])) break; if (_sp > XB_SPIN_CAP) { atomicAdd(&(bar)[XB_TMO], 1u); break; } } } } while (0)

struct XcdBarrier {
    unsigned* bar; unsigned x;
    volatile LAS unsigned* st;
};

__device__ __forceinline__ XcdBarrier xcd_barrier_post(unsigned* bar, volatile LAS unsigned* st) {
    XcdBarrier b; b.bar = bar; b.x = xb_xcc_id(); b.st = st;
    if (threadIdx.x == 0) (void)xb_add(&bar[XB_XCNT(b.x)], 1u);
    return b;
}
__device__ __forceinline__ void xcd_barrier_complete(unsigned* bar, unsigned x, unsigned& nloc, unsigned& nx) {
    const unsigned G = gridDim.x * gridDim.y * gridDim.z;
    unsigned sum, cnt, mine, sp = 0u;
    for (;;) {
        sum = 0u; cnt = 0u; mine = 0u;
#pragma unroll
        for (unsigned j = 0; j < 16; ++j) { const unsigned c = xb_ld(&bar[XB_XCNT(j)]); sum += c; cnt += (c > 0u) ? 1u : 0u; mine = (j == x) ? c : mine; }
        if (sum == G) break;
        __builtin_amdgcn_s_sleep(1);
        if ((++sp & 255u) == 0u) { if (xb_ld(&bar[XB_TMO])) break; if (sp > XB_SPIN_CAP) { atomicAdd(&bar[XB_TMO], 1u); break; } }
    }
    nloc = mine > 0u ? mine : 1u; nx = cnt > 0u ? cnt : 1u;
}

__device__ __forceinline__ void xcd_barrier(const XcdBarrier& b) {
    asm volatile("s_waitcnt vmcnt(0)" ::: "memory");
    __syncthreads();
    if (threadIdx.x == 0) {
        unsigned* bar = b.bar; asm volatile("" : "+v"(bar));
        __builtin_amdgcn_s_waitcnt(0);
        unsigned nloc = b.st[0], nx = b.st[1];
        if (nloc == 0u) { xcd_barrier_complete(bar, b.x, nloc, nx); b.st[0] = nloc; b.st[1] = nx; }
        const unsigned old = xb_add(&bar[XB_XSUB(b.x)], 1u);
        const unsigned gen = old / nloc;
        if (old + 1u == (gen + 1u) * nloc) {
            __builtin_amdgcn_fence(__ATOMIC_RELEASE, "agent");
            asm volatile("s_waitcnt vmcnt(0)" ::: "memory");
            const unsigned og = xb_add(&bar[XB_TOP], 1u);
            const unsigned tg = og / nx;
            if (og + 1u == (tg + 1u) * nx) xb_add(&bar[XB_TOPGEN], 1u);
            else XB_SPIN(xb_ld(&bar[XB_TOPGEN]) == tg, bar);
            __builtin_amdgcn_fence(__ATOMIC_ACQUIRE, "agent");
            xb_add(&bar[XB_XGEN(b.x)], 1u);
            asm volatile("s_waitcnt vmcnt(0)" ::: "memory");
        } else {
            XB_SPIN(xb_ld(&bar[XB_XGEN(b.x)]) == gen, bar);
            __builtin_amdgcn_fence(__ATOMIC_ACQUIRE, "agent");
            asm volatile("s_waitcnt vmcnt(0)" ::: "memory");
        }
    }
    __syncthreads();
}
__device__ void run_phase(const Params& p, LAS unsigned char* lds, int ph) {
    unsigned char* ws = p.ws; float* outp_ = p.out; asm volatile("" : "+s"(ws), "+s"(outp_)); const int z = lz();
    const int bid = lbid(), nb = gridDim.x;
    float* X = (float*)(ws + WS_X); bf16_t* Xb = (bf16_t*)(ws + WS_XB); float* ss = (float*)(ws + WS_SS);
    bf16_t* proj = (bf16_t*)(ws + WS_PROJ); bf16_t* Ob = (bf16_t*)(ws + WS_O);
    if (ph == 0) { phase0(p, lds); return; }
    if (ph == 25) {
        const int tid_ = ltid(), wid = tid_ >> 6, lane = tid_ & 63;
        for (int row0 = bid * 8 + wid; row0 < MR; row0 += nb * 16) {
            f32x4 v[2][4];
#pragma unroll
            for (int r2 = 0; r2 < 2; ++r2) {
                const int row = row0 + r2 * nb * 8;
                if (row < MR) {
#pragma unroll
                    for (int i = 0; i < 4; ++i) {
                        const int c = i * 256 + lane * 4;
                        if (row < NPR) { const u32x2 w = *(const u32x2*)(Xb + (size_t)row * 1024 + c); v[r2][i] = (f32x4){bflo(w.x), bfhi(w.x), bflo(w.y), bfhi(w.y)}; }
                        else v[r2][i] = *(const f32x4*)(X + (size_t)row * 1024 + c);
                    }
                }
            }
#pragma unroll
            for (int r2 = 0; r2 < 2; ++r2) {
                const int row = row0 + r2 * nb * 8;
                if (row < MR) {
                    float q = 0.f;
#pragma unroll
                    for (int i = 0; i < 4; ++i) q += (v[r2][i][0] * v[r2][i][0] + v[r2][i][1] * v[r2][i][1]) + (v[r2][i][2] * v[r2][i][2] + v[r2][i][3] * v[r2][i][3]);
                    const float rs = 1.0f / sqrtf(wave_sum(q) * (1.0f / 1024.0f) + EPSN);
#pragma unroll
                    for (int i = 0; i < 4; ++i) { const int c = i * 256 + lane * 4; const f32x4 g = *(const f32x4*)(p.in[z + 21] + c); *(f32x4*)(outp_ + (size_t)row * 1024 + c) = v[r2][i] * rs * g; }
                }
            }
        }
        return;
    }
    int l, sub; bool isA;
    if (ph < 15) { isA = true; l = (ph - 1) / 7; sub = (ph - 1) % 7; } else { isA = false; l = 2 + (ph - 15) / 5; sub = (ph - 15) % 5; }
    const int gsub = isA ? sub : (sub == 0 ? 0 : sub == 1 ? 3 : sub + 2);
    const float* ss_mix = ss + (size_t)(2 * l) * NPR * 16; float* ss_mlp = ss + (size_t)(2 * l + 1) * NPR * 16; float* ss_next = ss + (size_t)(2 * l + 2) * NPR * 16;
    if (gsub == 0) {
        if (isA) {
            warm_weights(lds, (const bf16_t*)(ws + WS_WINA) + (size_t)l * 3328 * 1024, 3328 * 1024 * 2);
            EpiProj<0, 0> E; E.O = proj; E.ldc = 3328; E.ss = ss_mix; E.O2 = nullptr; E.outp = nullptr;
            for (int step = 0; step < 2; ++step) {
                if ((step == 0) != (((bid >> 3) & 1) != 0)) {
            skinny_gemm<0, 0, 4, 4>(p, lds, (const bf16_t*)(ws + WS_XSB), 1024, (const bf16_t*)(ws + WS_WINA) + (size_t)l * 3328 * 1024, 3328, 1024, proj, 3328);
                } else {
            run_gemm(lds, Xb, (const bf16_t*)(ws + WS_WINA) + (size_t)l * 3328 * 1024, NPR, 3328, 1024, E);
                }
            }
            if (l == 0) { EpiMemKV M; M.outp = outp_; M.rsm = (const float*)(ws + WS_RSM); M.mkv = (bf16_t*)(ws + WS_MKV); run_gemm(lds, (const bf16_t*)(ws + WS_MEMB), (const bf16_t*)(ws + WS_WMEM), 1024, 2048, 1024, M, 64); }
            if (l == 0) { convert_tiles(p, lds, p.tcut[0], p.tcut[1], 96, 160); copy_swa_cache(p, 0, 96, 160); } else { convert_tiles(p, lds, p.tcut[1], p.tcut[2], 64, 192); copy_swa_cache(p, 1, 64, 192); }
        } else if (l == 2) {
            warm_weights(lds, (const bf16_t*)(ws + WS_WINB0), 1536 * 1024 * 2);
            EpiProj<0, 1> E; E.O = proj; E.ldc = 1024; E.ss = ss_mix; E.O2 = (bf16_t*)(ws + WS_KVS); E.outp = outp_;
            for (int step = 0; step < 2; ++step) {
                if ((step == 0) != (((bid >> 3) & 1) != 0)) {
            skinny_gemm<0, 3, 4, 2>(p, lds, (const bf16_t*)(ws + WS_XSB), 1024, (const bf16_t*)(ws + WS_WINB0), 1536, 1024, proj, 1024);
                } else {
            run_gemm(lds, Xb, (const bf16_t*)(ws + WS_WINB0), NPR, 1536, 1024, E);
                }
            }
            convert_tiles(p, lds, p.tcut[2], p.tcut[3], 128, 128); copy_swa_cache(p, 2, 128, 128);
        } else {
            warm_weights(lds, (const bf16_t*)(ws + WS_WINB1), 1024 * 1024 * 2);
            EpiProj<0, 0> E; E.O = proj; E.ldc = 1024; E.ss = ss_mix; E.O2 = nullptr; E.outp = nullptr;
            for (int step = 0; step < 2; ++step) {
                if ((step == 0) != (((bid >> 3) & 1) != 0)) {
            skinny_gemm<0, 0, 4, 1>(p, lds, (const bf16_t*)(ws + WS_XSB), 1024, (const bf16_t*)(ws + WS_WINB1), 1024, 1024, proj, 1024);
                } else {
            run_gemm(lds, Xb, (const bf16_t*)(ws + WS_WINB1), NPR, 1024, 1024, E);
                }
            }
        }
    } else if (gsub == 1) {
        ret_kvchunk_items(p, lds, bid, 768, nb);
    } else if (gsub == 2) {
        ret_scan(p, l);
    } else if (gsub == 3) {
        const bool dfirst = ((bid >> 3) & 1) != 0;
        for (int step = 0; step < 2; ++step) {
            if ((step == 0) == dfirst) {
                if (isA) {
                    ret_decode_items(p, lds, l, bid, 768, nb);
                    for (int qd = bid; qd < 128; qd += nb) decode_quad<0>(p, lds, l, 0, qd, 512, 3328, 3072);
                } else {
                    for (int qd = bid; qd < 384; qd += nb) decode_quad<1>(p, lds, l, l - 2, qd, 1536, 1024, 768);
                    if (bid >= 128) decode_quad<0>(p, lds, l, l - 2, bid - 128, 512, 1024, 768);
                }
            } else {
                if (isA) {
                    ret_out_items(p, lds, bid, 768, nb);
                    { const AttnArgs Am = mem_attn_args(p, l, bid, 3328, 3072); KVRegs r0, r1; attn_fetch(Am, r0); attn_group<0>(lds, Am, r0, nullptr, r1); }
                } else {
                    {
                        const AttnArgs A1 = swa_args(p, l - 2, bid, 1024), A2 = swa_args(p, l - 2, bid + 256, 1024), Am = mem_attn_args(p, l, bid, 1024, 768);
                        KVRegs r0, r1; attn_fetch(A1, r0);
                        attn_group<1>(lds, A1, r0, &A2, r1);
                        attn_group<1>(lds, A2, r1, &Am, r0);
                        attn_group<0>(lds, Am, r0, nullptr, r1);
                    }
                }
            }
        }
    } else if (gsub == 4) {
        warm_weights(lds, (const bf16_t*)(ws + WS_WOUT) + (size_t)l * 1024 * 1024, 1024 * 1024 * 2);
        EpiResid E; E.Xb = Xb; E.ss = ss_mlp;
        for (int step = 0; step < 2; ++step) {
            if ((step == 0) != (((bid >> 3) & 1) != 0)) {
        skinny_gemm<1, 2, 4, 1>(p, lds, Ob + (size_t)NPR * 1024, 1024, (const bf16_t*)(ws + WS_WOUT) + (size_t)l * 1024 * 1024, 1024, 1024, nullptr, 0);
            } else {
        run_gemm(lds, Ob, (const bf16_t*)(ws + WS_WOUT) + (size_t)l * 1024 * 1024, NPR, 1024, 1024, E);
            }
        }
    } else if (gsub == 5) {
        warm_weights(lds, (const bf16_t*)(ws + WS_WUP) + (size_t)l * 4096 * 1024, 4096 * 1024 * 2);
        EpiProj<1, 0> E; E.O = proj; E.ldc = 4096; E.ss = ss_mlp; E.O2 = nullptr; E.outp = nullptr;
        for (int step = 0; step < 2; ++step) {
            if ((step == 0) != (((bid >> 3) & 1) != 0)) {
        skinny_gemm<0, 1, 4, 4>(p, lds, (const bf16_t*)(ws + WS_XSB), 1024, (const bf16_t*)(ws + WS_WUP) + (size_t)l * 4096 * 1024, 4096, 1024, proj, 4096);
            } else {
        run_gemm(lds, Xb, (const bf16_t*)(ws + WS_WUP) + (size_t)l * 4096 * 1024, NPR, 4096, 1024, E);
            }
        }
    } else {
        warm_weights(lds, (const bf16_t*)(ws + WS_WDOWN) + (size_t)l * 4096 * 1024, 4096 * 1024 * 2);
        EpiResid E; E.Xb = Xb; E.ss = ss_next;
        for (int step = 0; step < 2; ++step) {
            if ((step == 0) != (((bid >> 3) & 1) != 0)) {
        skinny_gemm<1, 2, 8, 2>(p, lds, proj + (size_t)NPR * 4096, 4096, (const bf16_t*)(ws + WS_WDOWN) + (size_t)l * 4096 * 1024, 1024, 4096, nullptr, 0);
            } else {
        run_gemm(lds, proj, (const bf16_t*)(ws + WS_WDOWN) + (size_t)l * 4096 * 1024, NPR, 1024, 4096, E);
            }
        }
    }
}

__global__ __launch_bounds__(512, 2) void fwd_megakernel(Params p) {
    extern __shared__ __attribute__((aligned(16))) unsigned char shm[];
    LAS unsigned char* lds = (LAS unsigned char*)shm;
    volatile LAS unsigned* st = (volatile LAS unsigned*)(lds + (LDS_BYTES - 16));
    if (threadIdx.x == 0) { st[0] = 0u; st[1] = 0u; }
    __syncthreads();
    const bool multi = (p.ph_hi - p.ph_lo) > 1;
    XcdBarrier xb;
    if (multi) {
        cg::grid_group grid = cg::this_grid();
        xb = xcd_barrier_post((unsigned*)(p.ws + WS_BAR), st);
        grid.sync();
    }
    for (int ph = p.ph_lo; ph < p.ph_hi; ++ph) {
        run_phase(p, lds, ph);
        if (ph + 1 < p.ph_hi) xcd_barrier(xb);
    }
}

extern "C" void kernel_launch(void* const* d_in, const int* in_sizes, int n_in, void* d_out, int out_size, void* d_ws, size_t ws_size, hipStream_t stream) {
    static int grid = 0;
    if (grid == 0) {
        int dev = 0, cus = 0, per_cu = 0;
        hipGetDevice(&dev); hipDeviceGetAttribute(&cus, hipDeviceAttributeMultiprocessorCount, dev);
        if (hipFuncSetAttribute((const void*)fwd_megakernel, hipFuncAttributeMaxDynamicSharedMemorySize, LDS_BYTES) != hipSuccess) { fprintf(stderr, "hipFuncSetAttribute failed\n"); }
        hipOccupancyMaxActiveBlocksPerMultiprocessor(&per_cu, (const void*)fwd_megakernel, 512, LDS_BYTES);
        if (per_cu < 1) per_cu = 1;
        grid = cus * per_cu; (void)hipGetLastError();
        if (ws_size < WS_END) { fprintf(stderr, "workspace too small: %zu < %zu\n", ws_size, (size_t)WS_END); grid = -1; }
    }
    if (grid < 0) return;
    Params p; memset(&p, 0, sizeof(p));
    for (int i = 0; i < 22; ++i) p.in[i] = (const float*)d_in[i];
    p.out = (float*)d_out; p.ws = (unsigned char*)d_ws;
    unsigned char* ws = (unsigned char*)d_ws;
    int nj = 0, ts = 0;
    auto add = [&](const float* src, const float* g, size_t dst_off, int K, int N) {
        Job& j = p.jobs[nj++]; j.src = src; j.g = g; j.dst = (bf16_t*)(ws + dst_off); j.K = K; j.N = N; j.tstart = ts; j.pad = 0; ts += (K / 64) * (N / 64); };
    const float* nmix = p.in[8]; const float* nmem = p.in[14]; const float* nmlp = p.in[18];
    auto up = [&](int l) { add(p.in[19] + (size_t)l * 1024 * 4096, nmlp + l * 1024, WS_WUP + (size_t)l * 4096 * 1024 * 2, 1024, 4096); };
    auto down = [&](int l) { add(p.in[20] + (size_t)l * 4096 * 1024, nullptr, WS_WDOWN + (size_t)l * 4096 * 1024 * 2, 4096, 1024); };
    auto ina = [&](int l) { add(p.in[9] + (size_t)l * 1024 * 3328, nmix + l * 1024, WS_WINA + (size_t)l * 3328 * 1024 * 2, 1024, 3328); };
    auto outa = [&](int l) { add(p.in[10] + (size_t)l * 1024 * 1024, nullptr, WS_WOUT + (size_t)l * 1024 * 1024 * 2, 1024, 1024); };
    auto outb = [&](int j) { add(p.in[12] + (size_t)j * 1024 * 1024, nullptr, WS_WOUT + (size_t)(2 + j) * 1024 * 1024 * 2, 1024, 1024); };
    ina(0); for (int l = 0; l < 4; ++l) add(p.in[15] + (size_t)l * 1024 * 512, nmem + l * 1024, WS_WMEM + (size_t)l * 512 * 1024 * 2, 1024, 512);
    outa(0); up(0); down(0); p.tcut[0] = ts;
    ina(1); outa(1); up(1); down(1); p.tcut[1] = ts;
    add(p.in[11], nmix + 2 * 1024, WS_WINB0, 1024, 1024); add(p.in[17], p.in[16], WS_WINB0 + 1024ull * 1024 * 2, 1024, 512);
    outb(0); up(2); down(2); add(p.in[11] + 1024 * 1024, nmix + 3 * 1024, WS_WINB1, 1024, 1024); outb(1);
    const int s2base = ts; up(3); p.tcut[2] = s2base + 200;
    down(3); p.tcut[3] = ts;
    p.njobs = nj; p.ntiles = ts;
#ifdef MULTI_LAUNCH
    for (int ph = 0; ph < NPHASE; ++ph) { p.ph_lo = ph; p.ph_hi = ph + 1; hipLaunchKernelGGL(fwd_megakernel, dim3(grid), dim3(512), LDS_BYTES, stream, p); }
#else
    p.ph_lo = 0; p.ph_hi = NPHASE;
    (void)hipMemsetAsync(ws + WS_BAR, 0, 16384, stream);
    void* args[] = {&p};
    hipError_t e = hipLaunchCooperativeKernel((const void*)fwd_megakernel, dim3(grid), dim3(512), args, LDS_BYTES, stream);
    if (e != hipSuccess) fprintf(stderr, "cooperative launch failed: %s (grid %d)\n", hipGetErrorString(e), grid);
#endif
}
```

```cpp
#include <hip/hip_runtime.h>
#include <hip/hip_cooperative_groups.h>
#include <cstdio>
#include <cstring>
namespace cg = cooperative_groups;
namespace pg8 {
#define PG8_LAS __attribute__((address_space(3)))
typedef unsigned short bf16_t;
typedef short bf16x8 __attribute__((ext_vector_type(8)));
typedef float f32x4 __attribute__((ext_vector_type(4)));
typedef unsigned u32x4 __attribute__((ext_vector_type(4)));
constexpr int BM = 256, BK = 64, HALF = 128, HTB = HALF * BK * 2  , STAGE_BYTES = 8 * HTB, NXCD = 8, WGM = 8;

__host__ __device__ __forceinline__ int lds_byte(int r, int c) { const int st = (r >> 4) * 2 + (c >> 5), rr = r & 15, cc = c & 31, ob = rr * 64 + cc * 2; return st * 1024 + (ob ^ (((ob >> 9) & 1) << 5)); }
__host__ __device__ __forceinline__ void stage_rc(int b, int& R, int& C) { const int st = b / 1024, sb = b % 1024, swz = sb ^ (((sb >> 9) & 1) << 5); R = (st >> 1) * 16 + swz / 64; C = (st & 1) * 32 + (swz % 64) / 2; }
__host__ __device__ __forceinline__ int perm32(int rho) { const int n = rho >> 4, i = rho & 15; return 8 * (i >> 2) + 4 * n + (i & 3); }

struct Unit { int pm, pn; };
struct Gemm { const bf16_t* A; const bf16_t* Bt; int M, N, K; };

struct StaticOrder {
    int nM, nN, nwg, G, c;
    __host__ __device__ void init(int M, int N, int G_, int c_) { nM = M / BM; nN = N / BM; nwg = nM * nN; G = G_; c = c_; }
    __host__ __device__ bool next(int i, Unit& u) const {
        const long L = (long)i * G + c; if (L >= nwg) return false;
        int wgid = (int)L; { const int q = nwg / NXCD, r = nwg % NXCD, xcd = wgid % NXCD, off = wgid / NXCD; wgid = (xcd < r ? xcd * (q + 1) : r * (q + 1) + (xcd - r) * q) + off; }
        const int nig = WGM * nN, gid = wgid / nig, fm = gid * WGM, gsz = (nM - fm) < WGM ? (nM - fm) : WGM;
        u.pm = fm + ((wgid % nig) % gsz); u.pn = (wgid % nig) / gsz; return true;
    }
    __device__ __forceinline__ void a_ready(const Unit&) const {}
    __device__ __forceinline__ void done(const Unit&) const {}
};
template <class Epi, class Sched, bool STAMP = false>
__device__ __forceinline__ void gemm_phase(PG8_LAS unsigned char* lds, const Gemm g, const Sched& S, const Epi& E, unsigned long long* stamps) {
    int tid_ = threadIdx.x; asm volatile("" : "+v"(tid_)); const int tid = tid_, wid = __builtin_amdgcn_readfirstlane(tid >> 6), lane = tid & 63, wr = wid >> 2, wc = wid & 3, fr = lane & 15, fq = lane >> 4;
    const int K = g.K, nt = K / BK;
    int ts_lo = 0, ts_hi = 0, nts = 0; const unsigned long long rt_entry = STAMP ? (unsigned long long)wall_clock64() : 0ull;
#define PG8_STAMP() do { if (STAMP && wid == 0 && nts < 64) { const unsigned long long _c = (unsigned long long)clock64(); \
        ts_lo = (lane == nts) ? (int)(unsigned)_c : ts_lo; ts_hi = (lane == nts) ? (int)(unsigned)(_c >> 32) : ts_hi; ++nts; } } while (0)
    PG8_STAMP();
    unsigned voffA[2], voffB[2];
#pragma unroll
    for (int i = 0; i < 2; ++i) { int R, C; stage_rc(tid * 16 + i * 8192, R, C); const int Rb = Epi::PERM ? ((R & ~31) + perm32(R & 31)) : R;
        voffA[i] = (unsigned)(R * K + C) * 2u; voffB[i] = (unsigned)(Rb * K + C) * 2u; }
    const size_t kstep = (size_t)(BK * 2);
    const size_t hstep = (size_t)HALF * K * 2;
    const size_t tstep = 2 * hstep;
    const unsigned ldsw = (unsigned)wid * 1024u;
    const int aoff = lds_byte(wr * 64 + fr, fq * 8), boff = lds_byte(wc * 32 + fr, fq * 8);
#define PG8_SA(b, h) (((b) * 2 + (h)) * HTB)
#define PG8_SB(b, h) ((4 + (b) * 2 + (h)) * HTB)
#define PG8_STAGE(bufoff, gbase, voff) do { _Pragma("unroll") for (int _i = 0; _i < 2; ++_i) \
        __builtin_amdgcn_global_load_lds((const unsigned*)((const char*)(gbase) + (voff)[_i]), (PG8_LAS unsigned*)(lds + (bufoff) + ldsw + _i * 8192), 16, 0, 0); } while (0)
#define PG8_LDA(dst, b, h) do { _Pragma("unroll") for (int m = 0; m < 4; ++m) _Pragma("unroll") for (int k = 0; k < 2; ++k) dst[m][k] = *(const PG8_LAS bf16x8*)(lds + PG8_SA(b, h) + aoff + m * 2048 + k * 1024); } while (0)
#define PG8_LDB(dst, b, h) do { _Pragma("unroll") for (int n = 0; n < 2; ++n) _Pragma("unroll") for (int k = 0; k < 2; ++k) dst[n][k] = *(const PG8_LAS bf16x8*)(lds + PG8_SB(b, h) + boff + n * 2048 + k * 1024); } while (0)
#define PG8_MMA(ai, bj, At, Bt) do { __builtin_amdgcn_s_setprio(1); _Pragma("unroll") for (int m = 0; m < 4; ++m) _Pragma("unroll") for (int n = 0; n < 2; ++n) _Pragma("unroll") for (int k = 0; k < 2; ++k) \
        acc[ai][bj][m][n] = __builtin_amdgcn_mfma_f32_16x16x32_bf16(Bt[n][k], At[m][k], acc[ai][bj][m][n], 0, 0, 0); __builtin_amdgcn_s_setprio(0); } while (0)
#define PG8_WAIT_V(n) asm volatile("s_waitcnt vmcnt(" #n ")" ::: "memory")
#define PG8_WAIT_L(n) asm volatile("s_waitcnt lgkmcnt(" #n ")" ::: "memory")
#define PG8_BAR __builtin_amdgcn_s_barrier()
#define PG8_SCHED __builtin_amdgcn_sched_barrier(0)
    Unit cur, nxt; int ui = 0;
    if (!S.next(0, cur)) return;
    f32x4 acc[2][2][4][2];
#pragma unroll
    for (int a = 0; a < 2; ++a)
#pragma unroll
        for (int b = 0; b < 2; ++b)
#pragma unroll
            for (int m = 0; m < 4; ++m)
#pragma unroll
                for (int n = 0; n < 2; ++n) acc[a][b][m][n] = (f32x4){0.f, 0.f, 0.f, 0.f};
    bf16x8 At[4][2], B0[2][2], B1[2][2];
    const char* cA = (const char*)g.A + (size_t)cur.pm * tstep; const char* cB = (const char*)g.Bt + (size_t)cur.pn * tstep;
    S.a_ready(cur);
    PG8_STAGE(PG8_SB(0, 0), cB, voffB); PG8_STAGE(PG8_SA(0, 0), cA, voffA); PG8_STAGE(PG8_SB(0, 1), cB + hstep, voffB); PG8_STAGE(PG8_SA(0, 1), cA + hstep, voffA);
    if (wr == 1) PG8_BAR;
    PG8_WAIT_V(4); PG8_BAR;
    PG8_STAGE(PG8_SB(1, 0), cB + kstep, voffB); PG8_STAGE(PG8_SA(1, 0), cA + kstep, voffA); PG8_STAGE(PG8_SB(1, 1), cB + hstep + kstep, voffB);
    PG8_WAIT_V(6); PG8_BAR;
    PG8_STAMP();
    for (;;) {
        const bool has_next = S.next(ui + 1, nxt);
        const char* nA = has_next ? (const char*)g.A + (size_t)nxt.pm * tstep : cA; const char* nB = has_next ? (const char*)g.Bt + (size_t)nxt.pn * tstep : cB;
        for (int t = 0; t < nt; t += 2) {
            const bool last = (t == nt - 2);
            const char* a1 = cA + (size_t)(t + 1) * kstep;
            const char* a2 = last ? nA : cA + (size_t)(t + 2) * kstep; const char* b2 = last ? nB : cB + (size_t)(t + 2) * kstep;
            const char* a3 = a2 + kstep; const char* b3 = b2 + kstep;
            if (last && has_next) S.a_ready(nxt);
            PG8_LDB(B0, 0, 0); PG8_SCHED; PG8_LDA(At, 0, 0); PG8_STAGE(PG8_SA(1, 1), a1 + hstep, voffA);
            PG8_WAIT_L(8); PG8_BAR; PG8_WAIT_L(0); PG8_MMA(0, 0, At, B0); PG8_BAR; PG8_SCHED;
            PG8_LDB(B1, 0, 1); PG8_STAGE(PG8_SB(0, 0), b2, voffB);
            PG8_BAR; PG8_WAIT_L(0); PG8_MMA(0, 1, At, B1); PG8_BAR;
            PG8_LDA(At, 0, 1); PG8_STAGE(PG8_SA(0, 0), a2, voffA);
            PG8_BAR; PG8_WAIT_L(0); PG8_MMA(1, 0, At, B0); PG8_BAR; PG8_SCHED;
            PG8_STAGE(PG8_SB(0, 1), b2 + hstep, voffB);
            PG8_WAIT_V(6); PG8_BAR; PG8_MMA(1, 1, At, B1); PG8_BAR;
            PG8_LDB(B0, 1, 0); PG8_SCHED; PG8_LDA(At, 1, 0); PG8_STAGE(PG8_SA(0, 1), a2 + hstep, voffA);
            PG8_WAIT_L(8); PG8_BAR; PG8_WAIT_L(0); PG8_MMA(0, 0, At, B0); PG8_BAR; PG8_SCHED;
            PG8_LDB(B1, 1, 1); PG8_STAGE(PG8_SB(1, 0), b3, voffB);
            PG8_BAR; PG8_WAIT_L(0); PG8_MMA(0, 1, At, B1); PG8_BAR;
            PG8_LDA(At, 1, 1); PG8_STAGE(PG8_SA(1, 0), a3, voffA);
            PG8_BAR; PG8_WAIT_L(0); PG8_MMA(1, 0, At, B0); PG8_BAR; PG8_SCHED;
            PG8_STAGE(PG8_SB(1, 1), b3 + hstep, voffB);
            PG8_WAIT_V(6); PG8_BAR; PG8_MMA(1, 1, At, B1); PG8_BAR;
        }
        PG8_STAMP();
        if constexpr (!Epi::AFTER_DRAIN) { E(acc, cur, wr, wc, fr, fq, lds, ui); S.done(cur); }
        PG8_STAMP();
        if (!has_next) break;
#pragma unroll
        for (int a = 0; a < 2; ++a)
#pragma unroll
            for (int b = 0; b < 2; ++b)
#pragma unroll
                for (int m = 0; m < 4; ++m)
#pragma unroll
                    for (int n = 0; n < 2; ++n) acc[a][b][m][n] = (f32x4){0.f, 0.f, 0.f, 0.f};
        cur = nxt; cA = nA; cB = nB; ++ui;
    }
    PG8_WAIT_V(0);
    if (wr == 0) PG8_BAR;
    PG8_BAR;
    if constexpr (Epi::AFTER_DRAIN) { E.fused(acc, cur, wr, wc, fr, fq, lds, wid, lane); S.done(cur); }
    PG8_STAMP();
    if (STAMP && wid == 0) { stamps[lane] = lane < nts ? (((unsigned long long)(unsigned)ts_hi << 32) | (unsigned)ts_lo) : 0ull;
        if (lane == 62) stamps[62] = rt_entry; if (lane == 63) stamps[63] = (unsigned long long)wall_clock64(); }
#undef PG8_STAMP
#undef PG8_SA
#undef PG8_SB
#undef PG8_STAGE
#undef PG8_LDA
#undef PG8_LDB
#undef PG8_MMA
#undef PG8_WAIT_V
#undef PG8_WAIT_L
#undef PG8_BAR
#undef PG8_SCHED
}
}

#define LAS __attribute__((address_space(3)))
typedef unsigned short bf16_t;
typedef short bf16x8 __attribute__((ext_vector_type(8)));
typedef float f32x4 __attribute__((ext_vector_type(4)));
typedef unsigned u32x4 __attribute__((ext_vector_type(4)));
typedef unsigned u32x2 __attribute__((ext_vector_type(2)));

constexpr int DM = 1024, NPR = 16384, NSM = 128, MR = 16512, MP = 16640;
constexpr float EPSN = 1e-6f;
constexpr int LDS_BYTES = 159744;
constexpr int NPHASE = 26;

constexpr size_t OFF_YP = 0, OFF_YS = 16777216, OFF_RP = 16908288, OFF_RS = 17694720, OFF_KP = 42860544, OFF_VP = 42991616,
                 OFF_KS = 43122688, OFF_VS = 47316992, OFF_MK = 51511296, OFF_MV = 52559872;
constexpr size_t WS_WINA = 0;
constexpr size_t WS_WOUT = WS_WINA + 2ull * 3328 * 1024 * 2;
constexpr size_t WS_WINB0 = WS_WOUT + 4ull * 1024 * 1024 * 2;
constexpr size_t WS_WINB1 = WS_WINB0 + 1536ull * 1024 * 2;
constexpr size_t WS_WMEM = WS_WINB1 + 1024ull * 1024 * 2;
constexpr size_t WS_WUP = WS_WMEM + 2048ull * 1024 * 2;
constexpr size_t WS_WDOWN = WS_WUP + 4ull * 4096 * 1024 * 2;
constexpr size_t WS_X = WS_WDOWN + 4ull * 4096 * 1024 * 2;
constexpr size_t WS_XB = WS_X + (size_t)MP * 1024 * 4;
constexpr size_t WS_PROJ = WS_XB + (size_t)MP * 1024 * 2;
constexpr size_t WS_O = WS_PROJ + (size_t)MP * 4096 * 2;
constexpr size_t WS_KVS = WS_O + (size_t)MP * 1024 * 2;
constexpr size_t WS_KVC = WS_KVS + (size_t)MP * 512 * 2;
constexpr size_t WS_MEMB = WS_KVC + 768ull * 16384 * 4;
constexpr size_t WS_SS = WS_MEMB + 1024ull * 1024 * 2;
constexpr size_t WS_RSM = WS_SS + 9ull * NPR * 16 * 4;
constexpr size_t WS_MKV = WS_RSM + 4096;
constexpr size_t WS_XSB = WS_MKV + 1024ull * 2048 * 2;
constexpr size_t WS_BAR = WS_XSB + 128ull * 1024 * 2;
constexpr size_t WS_END = WS_BAR + 16384;

struct Job { const float* src; const float* g; bf16_t* dst; int K, N, tstart, pad; };
struct Params {
    const float* in[22];
    float* out;
    unsigned char* ws;
    Job jobs[21];
    int njobs, ntiles, ph_lo, ph_hi;
    int tcut[4];
};


__device__ __forceinline__ int ltid() { int t = threadIdx.x; asm volatile("" : "+v"(t)); return t; }
__device__ __forceinline__ int lbid() { int t = blockIdx.x; asm volatile("" : "+s"(t)); return t; }
__device__ __forceinline__ int lz() { int t = 0; asm volatile("" : "+s"(t)); return t; }
typedef float f32x2_ __attribute__((ext_vector_type(2)));
typedef __bf16 bf16x2_ __attribute__((ext_vector_type(2)));
__device__ __forceinline__ unsigned cvt2(float lo, float hi) { f32x2_ v = {lo, hi}; bf16x2_ b = __builtin_convertvector(v, bf16x2_); return __builtin_bit_cast(unsigned, b); }
__device__ __forceinline__ bf16_t f2bf(float f) { return (bf16_t)(cvt2(f, 0.f) & 0xffffu); }
__device__ __forceinline__ float bf2f(unsigned b) { return __uint_as_float(b << 16); }
__device__ __forceinline__ float bflo(unsigned w) { return __uint_as_float(w << 16); }
__device__ __forceinline__ float bfhi(unsigned w) { return __uint_as_float(w & 0xffff0000u); }
__device__ __forceinline__ bf16x8 ldfrag(const LAS bf16_t* base, int row, int stride, int k) { return *(const LAS bf16x8*)(base + row * stride + k); }
__device__ __forceinline__ f32x4 mfma16(bf16x8 a, bf16x8 b, f32x4 c) { return __builtin_amdgcn_mfma_f32_16x16x32_bf16(a, b, c, 0, 0, 0); }
__device__ __forceinline__ float wave_sum(float v) { for (int o = 32; o >= 1; o >>= 1) v += __shfl_xor(v, o); return v; }
__device__ __forceinline__ float wave_max(float v) { for (int o = 32; o >= 1; o >>= 1) v = fmaxf(v, __shfl_xor(v, o)); return v; }
__device__ __forceinline__ float log_gamma(int h) { return log1pf(-exp2f(-5.0f - (float)h)); }
__device__ __forceinline__ float alibi_slope(int hq) { return hq < 8 ? exp2f(-(float)(hq + 1)) : exp2f(-0.5f - (float)(hq - 8)); }

template <int ACT, int KV> struct EpiProj {
    static constexpr bool PERM = true, AFTER_DRAIN = false;
    bf16_t* O; int ldc; const float* ss; bf16_t* O2; float* outp;
    template <class Sched> __device__ __forceinline__ void prepass(const Sched& S, LAS unsigned char* lds) const {
        const int t = ltid(), r = t & 255, hf = t >> 8;
        f32x4 a[2][4]; bool ok[2];
#pragma unroll
        for (int ps = 0; ps < 2; ++ps) {
            pg8::Unit u; ok[ps] = S.next(ps * 2 + hf, u);
            if (ok[ps]) { const f32x4* sp = (const f32x4*)(ss + (size_t)(u.pm * 256 + r) * 16); a[ps][0] = sp[0]; a[ps][1] = sp[1]; a[ps][2] = sp[2]; a[ps][3] = sp[3]; }
        }
#pragma unroll
        for (int ps = 0; ps < 2; ++ps)
            if (ok[ps]) { const f32x4 s4 = (a[ps][0] + a[ps][1]) + (a[ps][2] + a[ps][3]);
                ((LAS float*)(lds + 131072))[(ps * 2 + hf) * 256 + r] = 1.0f / sqrtf(((s4[0] + s4[1]) + (s4[2] + s4[3])) * (1.0f / 1024.0f) + EPSN); }
        __syncthreads();
    }
    __device__ __forceinline__ void operator()(const f32x4 (&acc)[2][2][4][2], const pg8::Unit& u, int wr, int wc, int fr, int fq, LAS unsigned char* lds, int buf) const {
        const LAS float* rst = (const LAS float*)(lds + 131072) + buf * 256 + wr * 64 + fr;
        const int row0 = u.pm * 256 + wr * 64 + fr; int colt = u.pn * 256; bf16_t* base = O; int ld = ldc; bool kvt = false;
        if (KV && colt >= 1024) { kvt = true; colt -= 1024; base = O2; ld = 512; }
        const int col0 = colt + wc * 32 + 8 * fq;
#pragma unroll
        for (int ai = 0; ai < 2; ++ai)
#pragma unroll
            for (int m = 0; m < 4; ++m) {
                const int row = row0 + ai * 128 + m * 16;
                const float rs = rst[ai * 128 + m * 16];
                bf16_t* rowp = base + (size_t)row * ld + col0;
                float* fo = nullptr;
                if (KV && kvt) {
                    if (row < NPR) { const int pos = row & 4095; if (pos >= 3968) fo = outp + OFF_KP + ((size_t)((row >> 12) * 128 + (pos - 3968))) * 256; }
                }
#pragma unroll
                for (int bj = 0; bj < 2; ++bj) {
                    f32x4 v0 = acc[ai][bj][m][0] * rs, v1 = acc[ai][bj][m][1] * rs;
                    if (ACT == 1) {
#pragma unroll
                        for (int j = 0; j < 4; ++j) { float a = fmaxf(v0[j], 0.f), b = fmaxf(v1[j], 0.f); v0[j] = a * a; v1[j] = b * b; }
                    }
                    u32x4 w; w.x = cvt2(v0[0], v0[1]); w.y = cvt2(v0[2], v0[3]); w.z = cvt2(v1[0], v1[1]); w.w = cvt2(v1[2], v1[3]);
                    *(u32x4*)(rowp + bj * 128) = w;
                    if (KV && fo) {
                        const int c = col0 + bj * 128;
                        float* f = fo + (c >= 256 ? (c - 256) + (OFF_VP - OFF_KP) : c);
                        *(f32x4*)f = v0; *(f32x4*)(f + 4) = v1;
                    }
                }
            }
    }
};
struct EpiResid {
    static constexpr bool PERM = true, AFTER_DRAIN = false;
    bf16_t* Xb; float* ss;
    template <class Sched> __device__ __forceinline__ void prepass(const Sched&, LAS unsigned char*) const {}
    __device__ __forceinline__ void operator()(const f32x4 (&acc)[2][2][4][2], const pg8::Unit& u, int wr, int wc, int fr, int fq, LAS unsigned char*, int) const {
        const int row0 = u.pm * 256 + wr * 64 + fr, col0 = u.pn * 256 + wc * 32 + 8 * fq;
#pragma unroll
        for (int ai = 0; ai < 2; ++ai)
#pragma unroll
            for (int m = 0; m < 4; ++m) {
                const int row = row0 + ai * 128 + m * 16; bf16_t* xp = Xb + (size_t)row * 1024 + col0; float s = 0.f;
                const u32x4 o0 = *(const u32x4*)xp, o1 = *(const u32x4*)(xp + 128);
#pragma unroll
                for (int bj = 0; bj < 2; ++bj) {
                    const u32x4 o = bj ? o1 : o0;
                    const f32x4 a0 = acc[ai][bj][m][0], a1 = acc[ai][bj][m][1];
                    const float x0 = bflo(o.x) + a0[0], x1 = bfhi(o.x) + a0[1], x2 = bflo(o.y) + a0[2], x3 = bfhi(o.y) + a0[3];
                    const float x4 = bflo(o.z) + a1[0], x5 = bfhi(o.z) + a1[1], x6 = bflo(o.w) + a1[2], x7 = bfhi(o.w) + a1[3];
                    u32x4 w; w.x = cvt2(x0, x1); w.y = cvt2(x2, x3); w.z = cvt2(x4, x5); w.w = cvt2(x6, x7);
                    *(u32x4*)(xp + bj * 128) = w;
                    s += ((x0 * x0 + x1 * x1) + (x2 * x2 + x3 * x3)) + ((x4 * x4 + x5 * x5) + (x6 * x6 + x7 * x7));
                }
                s += __shfl_xor(s, 16); s += __shfl_xor(s, 32);
                if (fq == 0) ss[(size_t)row * 16 + u.pn * 4 + wc] = s;
            }
    }
};
struct EpiMemKV {
    static constexpr bool PERM = false, AFTER_DRAIN = false;
    float* outp; const float* rsm; bf16_t* mkv;
    template <class Sched> __device__ __forceinline__ void prepass(const Sched&, LAS unsigned char*) const {}
    __device__ __forceinline__ void operator()(const f32x4 (&acc)[2][2][4][2], const pg8::Unit& u, int wr, int wc, int fr, int fq, LAS unsigned char*, int) const {
        const int row0 = u.pm * 256 + wr * 64 + fr, col0 = u.pn * 256 + wc * 32 + 4 * fq;
#pragma unroll
        for (int ai = 0; ai < 2; ++ai)
#pragma unroll
            for (int m = 0; m < 4; ++m) {
                const int row = row0 + ai * 128 + m * 16; const float rs = rsm[row];
#pragma unroll
                for (int bj = 0; bj < 2; ++bj)
#pragma unroll
                    for (int n = 0; n < 2; ++n) {
                        const int c = col0 + bj * 128 + n * 16, l = c >> 9, kv = (c >> 8) & 1, cc = c & 255;
                        float* dst = outp + (kv ? OFF_MV : OFF_MK) + (size_t)l * (1024 * 256) + (size_t)row * 256 + cc;
                        const f32x4 v = acc[ai][bj][m][n] * rs; *(f32x4*)dst = v;
                        u32x2 w; w.x = cvt2(v[0], v[1]); w.y = cvt2(v[2], v[3]); *(u32x2*)(mkv + (size_t)row * 2048 + c) = w;
                    }
            }
    }
};
template <class Epi> __device__ __forceinline__ void run_gemm(LAS unsigned char* lds, const bf16_t* A, const bf16_t* Bt, int M, int N, int K, const Epi& E, int coff = 0) {
    pg8::Gemm g; g.A = A; g.Bt = Bt; g.M = M; g.N = N; g.K = K;
    const int c_ = lbid() - coff; if (c_ < 0) return;
    pg8::StaticOrder S; S.init(M, N, (int)gridDim.x, c_);
    E.prepass(S, lds);
    pg8::gemm_phase<Epi, pg8::StaticOrder, false>(lds, g, S, E, nullptr);
}

__device__ __forceinline__ void convert_tiles(const Params& p, LAS unsigned char* lds, int lo, int hi, int b0, int nbk) {
    constexpr int SUBS = 4, TS = 512 / SUBS, NL = 1024 / TS, TPR = TS / 64, KSP = 64 / TPR;
    const int tid = ltid(), bid = lbid();
    if (bid < b0) return;
    const int sub = tid / TS, t8 = tid % TS;
    LAS float* tile = (LAS float*)lds + sub * (64 * 65);
    float4 v[NL]; float gk[NL]; bf16_t* dst = nullptr; int K = 0, k0 = 0, n0 = 0;
    auto fetch = [&](int t, float4 (&vv)[NL], float (&gg)[NL], bf16_t*& d, int& KK, int& kk0, int& nn0) {
        int j = 0;
        while (j + 1 < p.njobs && t >= p.jobs[j + 1].tstart) ++j;
        const float* src = p.jobs[j].src; const float* g = p.jobs[j].g; d = p.jobs[j].dst; KK = p.jobs[j].K; const int N = p.jobs[j].N, tl = t - p.jobs[j].tstart;
        const int ntn = N >> 6; kk0 = (tl / ntn) * 64; nn0 = (tl % ntn) * 64;
#pragma unroll
        for (int i = 0; i < NL; ++i) { const int k = (t8 >> 4) + (TS / 16) * i, n4 = (t8 & 15) * 4; vv[i] = *(const float4*)(src + (size_t)(kk0 + k) * N + nn0 + n4); gg[i] = g ? g[kk0 + k] : 1.0f; }
    };
    const int step = SUBS * nbk;
    int t = lo + SUBS * (bid - b0) + sub;
    bool have = t < hi;
    if (have) fetch(t, v, gk, dst, K, k0, n0);
    for (int tb = lo + SUBS * (bid - b0); tb < hi; tb += step) {
        const int tn = t + step; const bool have2 = tn < hi;
        float4 v2[NL]; float g2[NL]; bf16_t* dst2 = nullptr; int K2 = 0, k02 = 0, n02 = 0;
        if (have2) fetch(tn, v2, g2, dst2, K2, k02, n02);
        if (have) {
#pragma unroll
            for (int i = 0; i < NL; ++i) { const int k = (t8 >> 4) + (TS / 16) * i, n4 = (t8 & 15) * 4;
                tile[k * 65 + n4 + 0] = v[i].x * gk[i]; tile[k * 65 + n4 + 1] = v[i].y * gk[i]; tile[k * 65 + n4 + 2] = v[i].z * gk[i]; tile[k * 65 + n4 + 3] = v[i].w * gk[i]; }
        }
        __syncthreads();
        if (have) {
            const int n = t8 / TPR, kb = (t8 % TPR) * KSP;
#pragma unroll
            for (int h2 = 0; h2 < KSP / 8; ++h2) {
                const int k8 = kb + h2 * 8; u32x4 w;
                w.x = cvt2(tile[(k8 + 0) * 65 + n], tile[(k8 + 1) * 65 + n]); w.y = cvt2(tile[(k8 + 2) * 65 + n], tile[(k8 + 3) * 65 + n]);
                w.z = cvt2(tile[(k8 + 4) * 65 + n], tile[(k8 + 5) * 65 + n]); w.w = cvt2(tile[(k8 + 6) * 65 + n], tile[(k8 + 7) * 65 + n]);
                *(u32x4*)(dst + (size_t)(n0 + n) * K + k0 + k8) = w;
            }
        }
        __syncthreads();
#pragma unroll
        for (int i = 0; i < NL; ++i) { v[i] = v2[i]; gk[i] = g2[i]; }
        dst = dst2; K = K2; k0 = k02; n0 = n02; t = tn; have = have2;
    }
}
__device__ __forceinline__ void copy_swa_cache(const Params& p, int part, int b0, int nbk) {
    float* outp_ = p.out; asm volatile("" : "+s"(outp_)); const int z = lz();
    const int tid = ltid(), bid = lbid();
    if (bid < b0) return;
    const int per = 128 * 8128, tot3 = (2 * per) / 3 + 1, lo = part * tot3, hi = (lo + tot3 < 2 * per) ? lo + tot3 : 2 * per, stride = nbk * 512;
    auto srcp = [&](int i) -> const float4* { const int kv = i >= per ? 1 : 0, r = i - kv * per, b = r / 8128, c4 = r - b * 8128; return (const float4*)(p.in[z + 5 + kv] + (size_t)b * 32768 + 256 + c4 * 4); };
    auto dstp = [&](int i) -> float4* { const int kv = i >= per ? 1 : 0, r = i - kv * per, b = r / 8128, c4 = r - b * 8128; return (float4*)(outp_ + (kv ? OFF_VS : OFF_KS) + (size_t)b * 32768 + c4 * 4); };
    int i = lo + (bid - b0) * 512 + tid;
    for (; i + 3 * stride < hi; i += 4 * stride) {
        const float4 a = *srcp(i), b = *srcp(i + stride), c = *srcp(i + 2 * stride), d = *srcp(i + 3 * stride);
        *dstp(i) = a; *dstp(i + stride) = b; *dstp(i + 2 * stride) = c; *dstp(i + 3 * stride) = d;
    }
    for (; i < hi; i += stride) *dstp(i) = *srcp(i);
}
__device__ void phase0(const Params& p, LAS unsigned char* lds) {
    unsigned char* ws = p.ws; float* outp_ = p.out; asm volatile("" : "+s"(ws), "+s"(outp_)); const int z = lz();
    const int tid = ltid(), bid = lbid(), nb = gridDim.x, wid = tid >> 6, lane = tid & 63;
    convert_tiles(p, lds, 0, p.tcut[0], 0, nb);
    float* X = (float*)(ws + WS_X); bf16_t* Xb = (bf16_t*)(ws + WS_XB); float* ss = (float*)(ws + WS_SS);
    bf16_t* memb = (bf16_t*)(ws + WS_MEMB); float* rsm = (float*)(ws + WS_RSM);
    for (int row0 = bid * 8 + wid; row0 < MR + 1024; row0 += nb * 16) {
        float4 v[2][4];
#pragma unroll
        for (int r2 = 0; r2 < 2; ++r2) {
            const int row = row0 + r2 * nb * 8;
            if (row < MR + 1024) {
                const float* src = row < NPR ? p.in[z + 0] + (size_t)row * 1024 : row < MR ? p.in[z + 1] + (size_t)(row - NPR) * 1024 : p.in[z + 7] + (size_t)(row - MR) * 1024;
#pragma unroll
                for (int i = 0; i < 4; ++i) v[r2][i] = *(const float4*)(src + i * 256 + lane * 4);
            }
        }
#pragma unroll
        for (int r2 = 0; r2 < 2; ++r2) {
            const int row = row0 + r2 * nb * 8;
            if (row < MR + 1024) {
                float s = 0.f;
#pragma unroll
                for (int i = 0; i < 4; ++i) {
                    const float4 x = v[r2][i]; const int c = i * 256 + lane * 4;
                    s += x.x * x.x + x.y * x.y + x.z * x.z + x.w * x.w;
                    u32x2 w; w.x = cvt2(x.x, x.y); w.y = cvt2(x.z, x.w);
                    if (row < NPR) *(u32x2*)(Xb + (size_t)row * 1024 + c) = w;
                    else if (row < MR) { *(float4*)(X + (size_t)row * 1024 + c) = x; *(u32x2*)((bf16_t*)(ws + WS_XSB) + (size_t)(row - NPR) * 1024 + c) = w; }
                    else *(u32x2*)(memb + (size_t)(row - MR) * 1024 + c) = w;
                }
                s = wave_sum(s);
                if (row < NPR) { if (lane < 16) ss[(size_t)row * 16 + lane] = lane == 0 ? s : 0.f; } else if (row >= MR && lane == 0) rsm[row - MR] = 1.0f / sqrtf(s * (1.0f / 1024.0f) + EPSN);
            }
        }
    }
}

typedef short s16x4 __attribute__((ext_vector_type(4)));
__device__ __forceinline__ bf16x8 trfrag(const LAS bf16_t* base, int stride, int k0, int c0, int lane) {
    const int g = lane >> 4, q = (lane & 15) >> 2, pp = lane & 3;
    LAS bf16_t* a = (LAS bf16_t*)base + (k0 + 8 * g + q) * stride + c0 + 4 * pp;
    const s16x4 v0 = __builtin_amdgcn_ds_read_tr16_b64_v4i16((LAS s16x4*)a);
    const s16x4 v1 = __builtin_amdgcn_ds_read_tr16_b64_v4i16((LAS s16x4*)(a + 4 * stride));
    return __builtin_shufflevector(v0, v1, 0, 1, 2, 3, 4, 5, 6, 7);
}
constexpr int RS = 144;
__device__ __forceinline__ void ret_kvchunk_items(const Params& p, LAS unsigned char* lds, int it0, int it_end, int stride) {
    unsigned char* ws = p.ws; asm volatile("" : "+s"(ws));
    const int tid = ltid(), wid = tid >> 6, lane = tid & 63, fr = lane & 15, fq = lane >> 4;
    const bf16_t* proj = (const bf16_t*)(ws + WS_PROJ);
    LAS bf16_t* Ks = (LAS bf16_t*)lds; LAS bf16_t* Vs = Ks + 128 * RS;
    auto fetch = [&](int it, u32x4 (&kq)[4], u32x4 (&vq)[4]) {
        const int bh = it >> 5, n = it & 31, b = bh / 6, h = bh % 6, r0 = b * 4096 + n * 128;
#pragma unroll
        for (int i = 0; i < 4; ++i) {
            const int idx = tid + i * 512, tt = idx >> 4, c8 = (idx & 15) * 8;
            const bf16_t* src = proj + (size_t)(r0 + tt) * 3328 + h * 128 + c8;
            kq[i] = *(const u32x4*)(src + 768); vq[i] = *(const u32x4*)(src + 1536);
        }
    };
    u32x4 kq[4], vq[4];
    if (it0 < it_end) fetch(it0, kq, vq);
    for (int it = it0; it < it_end; it += stride) {
        const int h = (it >> 5) % 6;
        const float lg = log_gamma(h);
#pragma unroll
        for (int i = 0; i < 4; ++i) {
            const int idx = tid + i * 512, tt = idx >> 4, c8 = (idx & 15) * 8;
            const float sc = __expf((float)(127 - tt) * lg) * 0.08838834764831845f;
            u32x4 kw; kw.x = cvt2(bflo(kq[i].x) * sc, bfhi(kq[i].x) * sc); kw.y = cvt2(bflo(kq[i].y) * sc, bfhi(kq[i].y) * sc); kw.z = cvt2(bflo(kq[i].z) * sc, bfhi(kq[i].z) * sc); kw.w = cvt2(bflo(kq[i].w) * sc, bfhi(kq[i].w) * sc);
            *(LAS u32x4*)(Ks + tt * RS + c8) = kw; *(LAS u32x4*)(Vs + tt * RS + c8) = vq[i];
        }
        __syncthreads();
        if (it + stride < it_end) fetch(it + stride, kq, vq);
        f32x4 acc[8];
#pragma unroll
        for (int i = 0; i < 8; ++i) acc[i] = (f32x4){0.f, 0.f, 0.f, 0.f};
#pragma unroll
        for (int ks = 0; ks < 4; ++ks) {
            const bf16x8 a = trfrag(Ks, RS, ks * 32, wid * 16, lane);
#pragma unroll
            for (int nt = 0; nt < 8; ++nt) acc[nt] = mfma16(trfrag(Vs, RS, ks * 32, nt * 16, lane), a, acc[nt]);
        }
        bf16_t* dst = (bf16_t*)(ws + WS_KVC) + (size_t)it * 16384 + (wid * 16 + fr) * 128 + 4 * fq;
#pragma unroll
        for (int nt = 0; nt < 8; ++nt) { u32x2 w; w.x = cvt2(acc[nt][0], acc[nt][1]); w.y = cvt2(acc[nt][2], acc[nt][3]); *(u32x2*)(dst + nt * 16) = w; }
        __syncthreads();
    }
}
__device__ __forceinline__ void ret_scan(const Params& p, int l) {
    unsigned char* ws = p.ws; float* outp_ = p.out; asm volatile("" : "+s"(ws), "+s"(outp_));
    bf16_t* kvc = (bf16_t*)(ws + WS_KVC);
    for (int idx = lbid() * 512 + ltid(); idx < 24 * 2048; idx += gridDim.x * 512) {
        const int bh = idx >> 11, c8 = idx & 2047, h = bh % 6;
        const float gc = __expf(128.0f * log_gamma(h));
        bf16_t* base = kvc + (size_t)bh * 32 * 16384 + c8 * 8;
        f32x4 s0 = (f32x4){0.f, 0.f, 0.f, 0.f}, s1 = s0;
#pragma unroll 16
        for (int n = 0; n < 32; ++n) {
            const u32x4 t = *(const u32x4*)(base + (size_t)n * 16384);
            u32x4 w; w.x = cvt2(s0[0], s0[1]); w.y = cvt2(s0[2], s0[3]); w.z = cvt2(s1[0], s1[1]); w.w = cvt2(s1[2], s1[3]);
            *(u32x4*)(base + (size_t)n * 16384) = w;
            s0 = s0 * gc + (f32x4){bflo(t.x), bfhi(t.x), bflo(t.y), bfhi(t.y)}; s1 = s1 * gc + (f32x4){bflo(t.z), bfhi(t.z), bflo(t.w), bfhi(t.w)};
        }
        float* o = outp_ + OFF_RP + ((size_t)(l * 24 + bh)) * 16384 + c8 * 8;
        *(f32x4*)o = s0; *(f32x4*)(o + 4) = s1;
    }
}
struct RetPre { bf16x8 a[4]; u32x4 kq[4], vq[4], sq[4]; u32x2 gw[8]; };
__device__ __forceinline__ void ret_out_items(const Params& p, LAS unsigned char* lds, int it0, int it_end, int stride) {
    unsigned char* ws = p.ws; asm volatile("" : "+s"(ws));
    const int tid = ltid(), wid = __builtin_amdgcn_readfirstlane(tid >> 6), lane = tid & 63, fr = lane & 15, fq = lane >> 4;
    const bf16_t* proj = (const bf16_t*)(ws + WS_PROJ);
    LAS bf16_t* Ks = (LAS bf16_t*)lds; LAS bf16_t* Vs = Ks + 128 * RS; LAS bf16_t* Ss = Vs + 128 * RS; LAS bf16_t* Ps = Ss + 128 * RS;
    const int q = wid * 16 + fr;
    auto fetch = [&](int it, RetPre& r) {
        const int bh = it >> 5, n = it & 31, b = bh / 6, h = bh % 6, r0 = b * 4096 + n * 128;
        const bf16_t* sprev = (const bf16_t*)(ws + WS_KVC) + (size_t)it * 16384;
#pragma unroll
        for (int ks = 0; ks < 4; ++ks) r.a[ks] = *(const bf16x8*)(proj + (size_t)(r0 + q) * 3328 + h * 128 + ks * 32 + fq * 8);
#pragma unroll
        for (int i = 0; i < 4; ++i) {
            const int idx = tid + i * 512, tt = idx >> 4, c8 = (idx & 15) * 8;
            const bf16_t* src = proj + (size_t)(r0 + tt) * 3328 + h * 128 + c8;
            r.kq[i] = *(const u32x4*)(src + 768); r.vq[i] = *(const u32x4*)(src + 1536); r.sq[i] = *(const u32x4*)(sprev + tt * 128 + c8);
        }
#pragma unroll
        for (int nt = 0; nt < 8; ++nt) r.gw[nt] = *(const u32x2*)(proj + (size_t)(r0 + q) * 3328 + 2304 + h * 128 + nt * 16 + 4 * fq);
    };
    RetPre cur;
    if (it0 < it_end) fetch(it0, cur);
    for (int it = it0; it < it_end; it += stride) {
        const int bh = it >> 5, n = it & 31, b = bh / 6, h = bh % 6, r0 = b * 4096 + n * 128;
        const float lg = log_gamma(h);
#pragma unroll
        for (int i = 0; i < 4; ++i) {
            const int idx = tid + i * 512, tt = idx >> 4, c8 = (idx & 15) * 8;
            *(LAS u32x4*)(Ks + tt * RS + c8) = cur.kq[i]; *(LAS u32x4*)(Vs + tt * RS + c8) = cur.vq[i]; *(LAS u32x4*)(Ss + tt * RS + c8) = cur.sq[i];
        }
        __syncthreads();
        RetPre nxt = cur;
        if (it + stride < it_end) fetch(it + stride, nxt);
        f32x4 acc[8];
    #pragma unroll
        for (int i = 0; i < 8; ++i) acc[i] = (f32x4){0.f, 0.f, 0.f, 0.f};
    #pragma unroll
        for (int ks = 0; ks < 4; ++ks) {
    #pragma unroll
            for (int nt = 0; nt < 8; ++nt) acc[nt] = mfma16(trfrag(Ss, RS, ks * 32, nt * 16, lane), cur.a[ks], acc[nt]);
            __builtin_amdgcn_sched_barrier(0);
        }
        const float wq = __expf((float)(q + 1) * lg);
    #pragma unroll
        for (int i = 0; i < 8; ++i) acc[i] *= wq;
    #pragma unroll
        for (int nt = 0; nt < 8; ++nt) {
            u32x2 w = (u32x2){0u, 0u};
            if (nt <= wid) {
                f32x4 sc = (f32x4){0.f, 0.f, 0.f, 0.f};
    #pragma unroll
                for (int ks = 0; ks < 4; ++ks) sc = mfma16(ldfrag(Ks, nt * 16 + fr, RS, ks * 32 + fq * 8), cur.a[ks], sc);
                float pv[4];
    #pragma unroll
                for (int j = 0; j < 4; ++j) { const int diff = q - (nt * 16 + 4 * fq + j); pv[j] = diff >= 0 ? sc[j] * 0.08838834764831845f * __expf((float)diff * lg) : 0.f; }
                w.x = cvt2(pv[0], pv[1]); w.y = cvt2(pv[2], pv[3]);
            }
            *(LAS u32x2*)(Ps + q * RS + nt * 16 + 4 * fq) = w;
        }
        asm volatile("s_waitcnt lgkmcnt(0)" ::: "memory");
        __builtin_amdgcn_wave_barrier();
        for (int ks = 0; ks <= (wid >> 1); ++ks) {
            const bf16x8 pa = ldfrag(Ps, q, RS, ks * 32 + fq * 8);
    #pragma unroll
            for (int nt = 0; nt < 8; ++nt) acc[nt] = mfma16(trfrag(Vs, RS, ks * 32, nt * 16, lane), pa, acc[nt]);
        }
        float s = 0.f;
    #pragma unroll
        for (int i = 0; i < 8; ++i) s += (acc[i][0] + acc[i][1]) + (acc[i][2] + acc[i][3]);
        s += __shfl_xor(s, 16); s += __shfl_xor(s, 32);
        const float mu = s * (1.0f / 128.0f);
        float v = 0.f;
    #pragma unroll
        for (int i = 0; i < 8; ++i) { const f32x4 d = acc[i] - mu; v += (d[0] * d[0] + d[1] * d[1]) + (d[2] * d[2] + d[3] * d[3]); }
        v += __shfl_xor(v, 16); v += __shfl_xor(v, 32);
        const float rstd = 1.0f / sqrtf(v * (1.0f / 128.0f) + EPSN);
        bf16_t* op = (bf16_t*)(ws + WS_O) + (size_t)(r0 + q) * 1024 + h * 128 + 4 * fq;
    #pragma unroll
        for (int nt = 0; nt < 8; ++nt) {
            const float g0 = bflo(cur.gw[nt].x), g1 = bfhi(cur.gw[nt].x), g2 = bflo(cur.gw[nt].y), g3 = bfhi(cur.gw[nt].y);
            const float o0 = (acc[nt][0] - mu) * rstd * (g0 * __builtin_amdgcn_rcpf(1.0f + __expf(-g0))), o1 = (acc[nt][1] - mu) * rstd * (g1 * __builtin_amdgcn_rcpf(1.0f + __expf(-g1)));
            const float o2 = (acc[nt][2] - mu) * rstd * (g2 * __builtin_amdgcn_rcpf(1.0f + __expf(-g2))), o3 = (acc[nt][3] - mu) * rstd * (g3 * __builtin_amdgcn_rcpf(1.0f + __expf(-g3)));
            u32x2 w; w.x = cvt2(o0, o1); w.y = cvt2(o2, o3);
            *(u32x2*)(op + nt * 16) = w;
        }
        __syncthreads();
        cur = nxt;
    }
}

constexpr int KS_ = 72, PS_ = 264;
struct KVRegs { u32x4 kq[4], vq[4]; bf16x8 a0, a1; };
struct AttnArgs { const bf16_t* Kb; int ldb, kv0; const bf16_t* Q0; int ldq; size_t qstep; bf16_t* O0; size_t ostep; int T, hq0; const float* sinks; };
__device__ __forceinline__ void attn_fetch(const AttnArgs& A, KVRegs& r) {
    const int tid = ltid(), wid = tid >> 6, lane = tid & 63, fr = lane & 15, fq = lane >> 4, q = wid * 16 + fr;
    r.a0 = *(const bf16x8*)(A.Q0 + (size_t)q * A.ldq + fq * 8); r.a1 = *(const bf16x8*)(A.Q0 + (size_t)q * A.ldq + 32 + fq * 8);
#pragma unroll
    for (int i = 0; i < 4; ++i) {
        const int idx = tid + i * 512, rr = idx >> 3, c8 = (idx & 7) * 8;
        r.kq[i] = (u32x4){0u, 0u, 0u, 0u}; r.vq[i] = (u32x4){0u, 0u, 0u, 0u};
        if (rr >= A.kv0) { r.kq[i] = *(const u32x4*)(A.Kb + (ptrdiff_t)rr * A.ldb + c8); r.vq[i] = *(const u32x4*)(A.Kb + 256 + (ptrdiff_t)rr * A.ldb + c8); }
    }
}
template <int SWA>
__device__ __forceinline__ void attn_group(LAS unsigned char* lds, const AttnArgs& A, const KVRegs& cur, const AttnArgs* nxtA, KVRegs& nxt) {
    const bf16_t* Q0 = A.Q0; const int ldq = A.ldq, kv0 = A.kv0, T = A.T, hq0 = A.hq0; const size_t qstep = A.qstep, ostep = A.ostep; bf16_t* O0 = A.O0; const float* sinks = A.sinks;
    const int tid = ltid(), wid = __builtin_amdgcn_readfirstlane(tid >> 6), lane = tid & 63, fr = lane & 15, fq = lane >> 4;
    LAS bf16_t* Ks = (LAS bf16_t*)lds; LAS bf16_t* Vs = Ks + 256 * KS_; LAS bf16_t* Ps = Vs + 256 * KS_;
    const int q = wid * 16 + fr;
    bf16x8 a0 = cur.a0, a1 = cur.a1;
#pragma unroll
    for (int i = 0; i < 4; ++i) {
        const int idx = tid + i * 512, r = idx >> 3, c8 = (idx & 7) * 8;
        *(LAS u32x4*)(Ks + r * KS_ + c8) = cur.kq[i]; *(LAS u32x4*)(Vs + r * KS_ + c8) = cur.vq[i];
    }
    __syncthreads();
    if (nxtA) attn_fetch(*nxtA, nxt);
    constexpr int NTL = SWA ? 9 : 16, NKS = SWA ? 5 : 8;
    const int nt0 = SWA ? wid : 0, ks0 = SWA ? (wid >> 1) : 0;
    for (int t = 0; t < T; ++t) {
        bf16x8 n0 = a0, n1 = a1;
        if (t + 1 < T) { const bf16_t* qn = Q0 + (size_t)(t + 1) * qstep + (size_t)q * ldq; n0 = *(const bf16x8*)(qn + fq * 8); n1 = *(const bf16x8*)(qn + 32 + fq * 8); }
        const float slope = SWA ? alibi_slope(hq0 + t) * 1.4426950408889634f : 0.f, sink = SWA ? sinks[hq0 + t] * 1.4426950408889634f : 0.f;
        int frl = fr; asm volatile("" : "+v"(frl));
        const float tb = -slope * (float)(128 + frl - 4 * fq);
        f32x4 sc[NTL];
        float mx = SWA ? sink : -INFINITY;
#pragma unroll
        for (int i = 0; i < NTL; ++i) {
            const int nt = nt0 + i;
            f32x4 s = (f32x4){0.f, 0.f, 0.f, 0.f};
            s = mfma16(ldfrag(Ks, nt * 16 + fr, KS_, fq * 8), a0, s);
            s = mfma16(ldfrag(Ks, nt * 16 + fr, KS_, 32 + fq * 8), a1, s);
            const bool tile_ok = !SWA || (nt * 16 >= kv0);
#pragma unroll
            for (int j = 0; j < 4; ++j) {
                float v;
                if (SWA) {
                    v = fmaf(s[j], 0.125f * 1.4426950408889634f, fmaf(slope, (float)(16 * i + j), tb));
                    bool ok = tile_ok;
                    if (i == 0) ok = ok && (4 * fq + j >= frl);
                    if (i == 8) ok = ok && (4 * fq + j <= frl);
                    v = ok ? v : -INFINITY;
                } else v = s[j] * (0.125f * 1.4426950408889634f);
                s[j] = v; mx = fmaxf(mx, v);
            }
            sc[i] = s;
            if ((i & 3) == 3) __builtin_amdgcn_sched_barrier(0);
        }
        mx = fmaxf(mx, __shfl_xor(mx, 16)); mx = fmaxf(mx, __shfl_xor(mx, 32));
        float sum = 0.f;
#pragma unroll
        for (int i = 0; i < NTL; ++i)
#pragma unroll
            for (int j = 0; j < 4; ++j) { const float e = __builtin_amdgcn_exp2f(sc[i][j] - mx); sc[i][j] = e; sum += e; }
        sum += __shfl_xor(sum, 16); sum += __shfl_xor(sum, 32);
        if (SWA) sum += __builtin_amdgcn_exp2f(sink - mx);
        const float inv = __builtin_amdgcn_rcpf(sum);
        asm volatile("" ::: "memory");
#pragma unroll
        for (int i = 0; i < NTL; ++i) { const f32x4 e = sc[i]; u32x2 w; w.x = cvt2(e[0], e[1]); w.y = cvt2(e[2], e[3]); *(LAS u32x2*)(Ps + q * PS_ + (nt0 + i) * 16 + 4 * fq) = w; }
        if (SWA) { const int zt = (wid & 1) ? wid - 1 : wid + 9; *(LAS u32x2*)(Ps + q * PS_ + zt * 16 + 4 * fq) = (u32x2){0u, 0u}; }
        asm volatile("s_waitcnt lgkmcnt(0)" ::: "memory");
        __builtin_amdgcn_wave_barrier();
        f32x4 acc[4];
#pragma unroll
        for (int i = 0; i < 4; ++i) acc[i] = (f32x4){0.f, 0.f, 0.f, 0.f};
#pragma unroll
        for (int i = 0; i < NKS; ++i) {
            const int ks = ks0 + i;
            const bf16x8 pa = ldfrag(Ps, q, PS_, ks * 32 + fq * 8);
#pragma unroll
            for (int nt = 0; nt < 4; ++nt) acc[nt] = mfma16(trfrag(Vs, KS_, ks * 32, nt * 16, lane), pa, acc[nt]);
            if (i & 1) __builtin_amdgcn_sched_barrier(0);
        }
        bf16_t* O = O0 + (size_t)t * ostep;
#pragma unroll
        for (int nt = 0; nt < 4; ++nt) { const f32x4 o = acc[nt] * inv; u32x2 w; w.x = cvt2(o[0], o[1]); w.y = cvt2(o[2], o[3]); *(u32x2*)(O + (size_t)q * 1024 + nt * 16 + 4 * fq) = w; }
        asm volatile("" ::: "memory");
        a0 = n0; a1 = n1;
    }
    __syncthreads();
}
__device__ __forceinline__ AttnArgs mem_attn_args(const Params& p, int l, int grp, int ldq, int qoff) {
    unsigned char* ws = p.ws; asm volatile("" : "+s"(ws));
    const int tp = grp & 15, h = (grp >> 4) & 3, b = grp >> 6;
    AttnArgs A;
    A.Q0 = (const bf16_t*)(ws + WS_PROJ) + (size_t)(b * 4096 + tp * 256) * ldq + qoff + h * 64;
    A.Kb = (const bf16_t*)(ws + WS_MKV) + (size_t)(b * 256) * 2048 + l * 512 + h * 64; A.ldb = 2048; A.kv0 = 0; A.ldq = ldq; A.qstep = (size_t)128 * ldq;
    A.O0 = (bf16_t*)(ws + WS_O) + (size_t)(b * 4096 + tp * 256) * 1024 + 768 + h * 64; A.ostep = (size_t)128 * 1024; A.T = 2; A.hq0 = 0; A.sinks = nullptr;
    return A;
}
__device__ __forceinline__ AttnArgs swa_args(const Params& p, int j, int grp, int ldq) {
    unsigned char* ws = p.ws; asm volatile("" : "+s"(ws)); const int z = lz();
    const int g = grp & 3, nbk = (grp >> 2) & 31, b = grp >> 7;
    AttnArgs A;
    A.Q0 = (const bf16_t*)(ws + WS_PROJ) + (size_t)(b * 4096 + nbk * 128) * ldq + g * 192;
    A.Kb = (const bf16_t*)(ws + WS_KVS) + ((ptrdiff_t)(b * 4096 + nbk * 128 - 128)) * 512 + g * 64; A.ldb = 512; A.kv0 = nbk == 0 ? 128 : 0; A.ldq = ldq; A.qstep = 64;
    A.O0 = (bf16_t*)(ws + WS_O) + (size_t)(b * 4096 + nbk * 128) * 1024 + g * 192; A.ostep = 64; A.T = 3; A.hq0 = g * 3; A.sinks = p.in[z + 13] + j * 12;
    return A;
}

__device__ float block_max(LAS float* red, float v) {
    v = wave_max(v); __syncthreads(); if ((threadIdx.x & 63) == 0) red[threadIdx.x >> 6] = v; __syncthreads();
    float r = red[0];
#pragma unroll
    for (int i = 1; i < 8; ++i) r = fmaxf(r, red[i]);
    return r;
}
__device__ float block_sum(LAS float* red, float v) {
    v = wave_sum(v); __syncthreads(); if ((threadIdx.x & 63) == 0) red[threadIdx.x >> 6] = v; __syncthreads();
    float r = 0.f;
#pragma unroll
    for (int i = 0; i < 8; ++i) r += red[i];
    return r;
}
template <int SWA>
__device__ __forceinline__ void decode_quad(const Params& p, LAS unsigned char* lds, int l, int j, int qd, int n_items, int ldq, int qoff_mem) {
    constexpr int NK = SWA ? 128 : 256, NTOT = NK + SWA;
    unsigned char* ws = p.ws; asm volatile("" : "+s"(ws)); const int z = lz();
    const int tid = ltid(), sg = tid >> 7, t = tid & 127, lane = tid & 63, w2 = (tid >> 6) & 1;
    const int it = qd * 4 + sg; const bool active = it < n_items; const int itc = active ? it : 0;
    const bf16_t* q; const float* K; const float* V; const bf16_t* kx = nullptr; bf16_t* out; float slope = 0.f, sink = 0.f;
    if (SWA) {
        const int hq = itc % 12, b = itc / 12, g = hq / 3;
        q = (const bf16_t*)(ws + WS_PROJ) + (size_t)(NPR + b) * ldq + hq * 64;
        K = p.in[z + 5] + ((size_t)b * 128) * 256 + g * 64; V = p.in[z + 6] + ((size_t)b * 128) * 256 + g * 64;
        kx = (const bf16_t*)(ws + WS_KVS) + (size_t)(NPR + b) * 512 + g * 64;
        slope = alibi_slope(hq); sink = p.in[z + 13][j * 12 + hq];
        out = (bf16_t*)(ws + WS_O) + (size_t)(NPR + b) * 1024 + hq * 64;
    } else {
        const int h = itc & 3, b = itc >> 2;
        q = (const bf16_t*)(ws + WS_PROJ) + (size_t)(NPR + b) * ldq + qoff_mem + h * 64;
        const size_t base = ((size_t)(l * 128 + b) * 256) * 256 + h * 64;
        K = p.in[z + 2] + base; V = p.in[z + 3] + base;
        out = (bf16_t*)(ws + WS_O) + (size_t)(NPR + b) * 1024 + 768 + h * 64;
    }
    LAS float* base = (LAS float*)lds + sg * 1024; LAS float* qs = base; LAS float* sc = base + 64; LAS float* part = base + 336; LAS float* red = base + 848;
    if (active && t < 64) qs[t] = bf2f(q[t]);
    __syncthreads();
    const int d4 = (t & 15) * 4, mg = t >> 4;
    constexpr int NVE = 16;
    f32x4 vv[NVE];
    if (active) {
        const int sub = t & 3, kr = t >> 2;
        f32x4 qv[4];
#pragma unroll
        for (int i = 0; i < 4; ++i) qv[i] = *(const LAS f32x4*)(qs + sub * 16 + i * 4);
        float sd[NK / 32];
#pragma unroll
        for (int pp = 0; pp < NK / 32; ++pp) {
            const float* kp = K + (size_t)(pp * 32 + kr) * 256 + sub * 16; float a = 0.f;
#pragma unroll
            for (int i = 0; i < 4; ++i) { const f32x4 kv = *(const f32x4*)(kp + i * 4); a += (kv[0] * qv[i][0] + kv[1] * qv[i][1]) + (kv[2] * qv[i][2] + kv[3] * qv[i][3]); }
            sd[pp] = a;
            if ((pp & 3) == 3) __builtin_amdgcn_sched_barrier(0);
        }
#pragma unroll
        for (int i = 0; i < NVE; ++i) vv[i] = *(const f32x4*)(V + (size_t)(mg + 8 * i) * 256 + d4);
#pragma unroll
        for (int pp = 0; pp < NK / 32; ++pp) {
            float a = sd[pp]; a += __shfl_xor(a, 1); a += __shfl_xor(a, 2);
            if (sub == 0) { float v = a * 0.125f; if (SWA) v -= slope * (float)(NK - (pp * 32 + kr)); sc[pp * 32 + kr] = v; }
        }
        if (SWA && w2 == 0) { const float v = wave_sum(qs[lane] * bf2f(kx[lane])); if (lane == 0) sc[NK] = v * 0.125f; }
    }
    __syncthreads();
    const float v0 = (active && t < NTOT) ? sc[t] : -INFINITY, v1 = (active && t + 128 < NTOT) ? sc[t + 128] : -INFINITY;
    { const float m = wave_max(fmaxf(v0, v1)); if (lane == 0) red[w2] = m; }
    __syncthreads();
    float mx = fmaxf(red[0], red[1]); if (SWA) mx = fmaxf(mx, sink);
    const float e0 = (active && t < NTOT) ? __expf(v0 - mx) : 0.f, e1 = (active && t + 128 < NTOT) ? __expf(v1 - mx) : 0.f;
    if (active && t < NTOT) sc[t] = e0;
    if (active && t + 128 < NTOT) sc[t + 128] = e1;
    { const float sm = wave_sum(e0 + e1); if (lane == 0) red[2 + w2] = sm; }
    __syncthreads();
    float sum = red[2] + red[3]; if (SWA) sum += __expf(sink - mx);
    if (active) {
        f32x4 acc = (f32x4){0.f, 0.f, 0.f, 0.f};
#pragma unroll
        for (int i = 0; i < NVE; ++i) acc += vv[i] * sc[mg + 8 * i];
#pragma unroll
        for (int i = NVE; i < NK / 8; ++i) acc += *(const f32x4*)(V + (size_t)(mg + 8 * i) * 256 + d4) * sc[mg + 8 * i];
        if (SWA && mg == 0) { const float pe = sc[NK]; const bf16_t* vx = kx + 256; acc[0] += pe * bf2f(vx[d4]); acc[1] += pe * bf2f(vx[d4 + 1]); acc[2] += pe * bf2f(vx[d4 + 2]); acc[3] += pe * bf2f(vx[d4 + 3]); }
        *(LAS f32x4*)(part + mg * 64 + d4) = acc;
    }
    __syncthreads();
    if (active && t < 64) { float sa = 0.f;
#pragma unroll
        for (int i = 0; i < 8; ++i) sa += part[i * 64 + t];
        out[t] = f2bf(sa / sum); }
    __syncthreads();
}
__device__ __forceinline__ void ret_decode_items(const Params& p, LAS unsigned char* lds, int l, int it0, int it_end, int stride) {
    unsigned char* ws = p.ws; float* outp_ = p.out; asm volatile("" : "+s"(ws), "+s"(outp_)); const int z = lz();
    const int tid = ltid(), lane = tid & 63, e4 = (tid & 31) * 4, dg = tid >> 5, w = tid >> 7, e = tid & 127;
    LAS float* qs = (LAS float*)lds; LAS float* ks = qs + 128; LAS float* vs = ks + 128; LAS float* gs = vs + 128; LAS float* part = gs + 128; LAS float* red = part + 2048;
    auto fetch = [&](int it, f32x4 (&S)[8], float& pv) {
        const int h = it % 6, b = it / 6;
        const float* S0 = p.in[z + 4] + ((size_t)((l * 128 + b) * 6 + h)) * 16384;
#pragma unroll
        for (int i = 0; i < 8; ++i) S[i] = *(const f32x4*)(S0 + (dg + 16 * i) * 128 + e4);
        pv = bf2f(((const bf16_t*)(ws + WS_PROJ))[(size_t)(NPR + b) * 3328 + h * 128 + w * 768 + e]);
    };
    f32x4 S[8]; float pv = 0.f;
    if (it0 < it_end) fetch(it0, S, pv);
    for (int it = it0; it < it_end; it += stride) {
        const int h = it % 6, b = it / 6;
        const float gamma = 1.0f - exp2f(-5.0f - (float)h);
        (w == 0 ? qs : w == 1 ? ks : w == 2 ? vs : gs)[e] = (w == 1) ? pv * 0.08838834764831845f : pv;
        __syncthreads();
        f32x4 Sn[8]; float pvn = 0.f;
#pragma unroll
        for (int i = 0; i < 8; ++i) Sn[i] = S[i];
        if (it + stride < it_end) fetch(it + stride, Sn, pvn);
        float* S1 = outp_ + OFF_RS + ((size_t)((l * 128 + b) * 6 + h)) * 16384;
        const f32x4 vv = (f32x4){vs[e4], vs[e4 + 1], vs[e4 + 2], vs[e4 + 3]};
        f32x4 o = (f32x4){0.f, 0.f, 0.f, 0.f};
#pragma unroll
        for (int i = 0; i < 8; ++i) { const int d = dg + 16 * i; const f32x4 sn = S[i] * gamma + vv * ks[d]; *(f32x4*)(S1 + d * 128 + e4) = sn; o += sn * qs[d]; }
        *(LAS f32x4*)(part + dg * 128 + e4) = o;
        __syncthreads();
        float sv = 0.f;
        if (tid < 128) {
#pragma unroll
            for (int i = 0; i < 16; ++i) sv += part[i * 128 + tid];
            const float s1 = wave_sum(sv), s2 = wave_sum(sv * sv);
            if (lane == 0) { red[2 * (tid >> 6)] = s1; red[2 * (tid >> 6) + 1] = s2; }
        }
        __syncthreads();
        if (tid < 128) {
            const float mu = (red[0] + red[2]) * (1.0f / 128.0f), var = fmaxf((red[1] + red[3]) * (1.0f / 128.0f) - mu * mu, 0.f);
            const float g = gs[tid];
            ((bf16_t*)(ws + WS_O))[(size_t)(NPR + b) * 1024 + h * 128 + tid] = f2bf((sv - mu) / sqrtf(var + EPSN) * (g * __builtin_amdgcn_rcpf(1.0f + __expf(-g))));
        }
        __syncthreads();
#pragma unroll
        for (int i = 0; i < 8; ++i) S[i] = Sn[i];
        pv = pvn;
    }
}


template <int AMODE, int EMODE, int KS, int NT>
__device__ __forceinline__ void skinny_gemm(const Params& p, LAS unsigned char* lds, const bf16_t* Aptr, int lda, const bf16_t* Wt, int N, int K, bf16_t* Ob, int ldo) {
    unsigned char* ws = p.ws; float* outp_ = p.out; asm volatile("" : "+s"(ws), "+s"(outp_));
    const int tid = ltid(), wid = tid >> 6, lane = tid & 63, fr = lane & 15, fq = lane >> 4, bid = lbid();
    const int nunits = 8 * (N / (16 * NT)) * KS, kslice = K / KS;
    LAS float* red = (LAS float*)lds;
    constexpr int RW = 4 * NT + 1;
    for (int u = bid * 8 + wid; u < nunits; u += (int)gridDim.x * 8) {
        const int ks = u % KS, mt = (u / KS) & 7, ng = u / (KS * 8), m0 = mt * 16, n0 = ng * 16 * NT, kb = ks * kslice;
        f32x4 acc[NT]; float ssq = 0.f;
#pragma unroll
        for (int i = 0; i < NT; ++i) acc[i] = (f32x4){0.f, 0.f, 0.f, 0.f};
        const bf16_t* wp = Wt + (size_t)(n0 + fr) * K + kb + fq * 8;
        const bf16_t* ap = Aptr + (size_t)(m0 + fr) * lda + kb + fq * 8;
        f32x4 xold[NT];
        if (EMODE == 2 && ks == 0) {
#pragma unroll
            for (int i = 0; i < NT; ++i) xold[i] = *(const f32x4*)((const float*)(ws + WS_X) + (size_t)(NPR + m0 + fr) * 1024 + n0 + i * 16 + 4 * fq);
        }
#pragma unroll 8
        for (int k = 0; k < kslice; k += 32) {
            const u32x4 aw = *(const u32x4*)(ap + k);
            if (AMODE == 0) {
                const float x0 = bflo(aw.x), x1 = bfhi(aw.x), x2 = bflo(aw.y), x3 = bfhi(aw.y), x4 = bflo(aw.z), x5 = bfhi(aw.z), x6 = bflo(aw.w), x7 = bfhi(aw.w);
                ssq += ((x0 * x0 + x1 * x1) + (x2 * x2 + x3 * x3)) + ((x4 * x4 + x5 * x5) + (x6 * x6 + x7 * x7));
            }
#pragma unroll
            for (int i = 0; i < NT; ++i) acc[i] = mfma16(*(const bf16x8*)(wp + (size_t)i * 16 * K + k), __builtin_bit_cast(bf16x8, aw), acc[i]);
        }
        if (KS > 1) {
            __syncthreads();
            LAS float* r = red + (wid * 64 + lane) * RW;
#pragma unroll
            for (int i = 0; i < NT; ++i) { r[4 * i] = acc[i][0]; r[4 * i + 1] = acc[i][1]; r[4 * i + 2] = acc[i][2]; r[4 * i + 3] = acc[i][3]; }
            r[4 * NT] = ssq;
            __syncthreads();
            if (ks == 0) {
#pragma unroll
                for (int j = 1; j < KS; ++j) { const LAS float* o = red + ((wid + j) * 64 + lane) * RW;
#pragma unroll
                    for (int i = 0; i < NT; ++i) { acc[i][0] += o[4 * i]; acc[i][1] += o[4 * i + 1]; acc[i][2] += o[4 * i + 2]; acc[i][3] += o[4 * i + 3]; }
                    ssq += o[4 * NT]; }
            }
        }
        if (ks == 0) {
            float rs = 1.0f;
            if (AMODE == 0) { ssq += __shfl_xor(ssq, 16); ssq += __shfl_xor(ssq, 32); rs = 1.0f / sqrtf(ssq * (1.0f / 1024.0f) + EPSN); }
            const int row = m0 + fr;
#pragma unroll
            for (int i = 0; i < NT; ++i) {
                const int col = n0 + i * 16 + 4 * fq;
                if (EMODE == 2) {
                    float* xp = (float*)(ws + WS_X) + (size_t)(NPR + row) * 1024 + col; const f32x4 x = xold[i] + acc[i]; *(f32x4*)xp = x;
                    u32x2 w; w.x = cvt2(x[0], x[1]); w.y = cvt2(x[2], x[3]); *(u32x2*)((bf16_t*)(ws + WS_XSB) + (size_t)row * 1024 + col) = w;
                } else {
                    f32x4 v = acc[i] * rs;
                    if (EMODE == 1) {
#pragma unroll
                        for (int j = 0; j < 4; ++j) { const float a = fmaxf(v[j], 0.f); v[j] = a * a; }
                    }
                    u32x2 w; w.x = cvt2(v[0], v[1]); w.y = cvt2(v[2], v[3]);
                    if (EMODE == 3 && col >= 1024) {
                        const int c = col - 1024;
                        *(u32x2*)((bf16_t*)(ws + WS_KVS) + (size_t)(NPR + row) * 512 + c) = w;
                        *(f32x4*)(outp_ + (c >= 256 ? OFF_VS : OFF_KS) + ((size_t)(row * 128 + 127)) * 256 + (c & 255)) = v;
                    } else *(u32x2*)(Ob + (size_t)(NPR + row) * ldo + col) = w;
                }
            }
        }
    }
    if (KS > 1) __syncthreads();
}

__device__ __forceinline__ void warm_weights(LAS unsigned char* lds, const bf16_t* W, int bytes_total) {
    const int tid = ltid(), wid = __builtin_amdgcn_readfirstlane(tid >> 6), lane = tid & 63, bid = lbid();
    const int per = bytes_total >> 8;
    const char* base = (const char*)W + (size_t)bid * per;
    for (int off = wid * 1024; off < per; off += 8192)
        __builtin_amdgcn_global_load_lds((const unsigned*)(base + off + lane * 16), (LAS unsigned*)(lds + 139264 + wid * 1024), 16, 0, 0);
}

#define XB_TMO      128
#define XB_XCNT(j)  (256  + 64 * (j))
#define XB_XSUB(j)  (1280 + 64 * (j))
#define XB_XGEN(j)  (2304 + 64 * (j))
#define XB_TOP      3328
#define XB_TOPGEN   3392
#define XCD_BAR_WORDS 3456
#define XB_SPIN_CAP (1u << 18)
__device__ __forceinline__ unsigned xb_ld(unsigned* p)              { return __hip_atomic_load(p, __ATOMIC_RELAXED, __HIP_MEMORY_SCOPE_AGENT); }
__device__ __forceinline__ unsigned xb_add(unsigned* p, unsigned v) { return __hip_atomic_fetch_add(p, v, __ATOMIC_RELAXED, __HIP_MEMORY_SCOPE_AGENT); }
__device__ __forceinline__ unsigned xb_xcc_id() { return (unsigned)__builtin_amdgcn_s_getreg((3 << 11) | 20) & 0xFu; }
#define XB_SPIN(cond, bar) do { unsigned _sp = 0; while (cond) { __builtin_amdgcn_s_sleep(1); \
    if ((++_sp & 255u) == 0u) { if (xb_ld(&(bar)[XB_TMO])) break; if (_sp > XB_SPIN_CAP) { atomicAdd(&(bar)[XB_TMO], 1u); break; } } } } while (0)

struct XcdBarrier {
    unsigned* bar; unsigned x;
    volatile LAS unsigned* st;
};

__device__ __forceinline__ XcdBarrier xcd_barrier_post(unsigned* bar, volatile LAS unsigned* st) {
    XcdBarrier b; b.bar = bar; b.x = xb_xcc_id(); b.st = st;
    if (threadIdx.x == 0) (void)xb_add(&bar[XB_XCNT(b.x)], 1u);
    return b;
}
__device__ __forceinline__ void xcd_barrier_complete(unsigned* bar, unsigned x, unsigned& nloc, unsigned& nx) {
    const unsigned G = gridDim.x * gridDim.y * gridDim.z;
    unsigned sum, cnt, mine, sp = 0u;
    for (;;) {
        sum = 0u; cnt = 0u; mine = 0u;
#pragma unroll
        for (unsigned j = 0; j < 16; ++j) { const unsigned c = xb_ld(&bar[XB_XCNT(j)]); sum += c; cnt += (c > 0u) ? 1u : 0u; mine = (j == x) ? c : mine; }
        if (sum == G) break;
        __builtin_amdgcn_s_sleep(1);
        if ((++sp & 255u) == 0u) { if (xb_ld(&bar[XB_TMO])) break; if (sp > XB_SPIN_CAP) { atomicAdd(&bar[XB_TMO], 1u); break; } }
    }
    nloc = mine > 0u ? mine : 1u; nx = cnt > 0u ? cnt : 1u;
}

__device__ __forceinline__ void xcd_barrier(const XcdBarrier& b) {
    asm volatile("s_waitcnt vmcnt(0)" ::: "memory");
    __syncthreads();
    if (threadIdx.x == 0) {
        unsigned* bar = b.bar; asm volatile("" : "+v"(bar));
        __builtin_amdgcn_s_waitcnt(0);
        unsigned nloc = b.st[0], nx = b.st[1];
        if (nloc == 0u) { xcd_barrier_complete(bar, b.x, nloc, nx); b.st[0] = nloc; b.st[1] = nx; }
        const unsigned old = xb_add(&bar[XB_XSUB(b.x)], 1u);
        const unsigned gen = old / nloc;
        if (old + 1u == (gen + 1u) * nloc) {
            __builtin_amdgcn_fence(__ATOMIC_RELEASE, "agent");
            asm volatile("s_waitcnt vmcnt(0)" ::: "memory");
            const unsigned og = xb_add(&bar[XB_TOP], 1u);
            const unsigned tg = og / nx;
            if (og + 1u == (tg + 1u) * nx) xb_add(&bar[XB_TOPGEN], 1u);
            else XB_SPIN(xb_ld(&bar[XB_TOPGEN]) == tg, bar);
            __builtin_amdgcn_fence(__ATOMIC_ACQUIRE, "agent");
            xb_add(&bar[XB_XGEN(b.x)], 1u);
            asm volatile("s_waitcnt vmcnt(0)" ::: "memory");
        } else {
            XB_SPIN(xb_ld(&bar[XB_XGEN(b.x)]) == gen, bar);
            __builtin_amdgcn_fence(__ATOMIC_ACQUIRE, "agent");
            asm volatile("s_waitcnt vmcnt(0)" ::: "memory");
        }
    }
    __syncthreads();
}
__device__ void run_phase(const Params& p, LAS unsigned char* lds, int ph) {
    unsigned char* ws = p.ws; float* outp_ = p.out; asm volatile("" : "+s"(ws), "+s"(outp_)); const int z = lz();
    const int bid = lbid(), nb = gridDim.x;
    float* X = (float*)(ws + WS_X); bf16_t* Xb = (bf16_t*)(ws + WS_XB); float* ss = (float*)(ws + WS_SS);
    bf16_t* proj = (bf16_t*)(ws + WS_PROJ); bf16_t* Ob = (bf16_t*)(ws + WS_O);
    if (ph == 0) { phase0(p, lds); return; }
    if (ph == 25) {
        const int tid_ = ltid(), wid = tid_ >> 6, lane = tid_ & 63;
        for (int row0 = bid * 8 + wid; row0 < MR; row0 += nb * 16) {
            f32x4 v[2][4];
#pragma unroll
            for (int r2 = 0; r2 < 2; ++r2) {
                const int row = row0 + r2 * nb * 8;
                if (row < MR) {
#pragma unroll
                    for (int i = 0; i < 4; ++i) {
                        const int c = i * 256 + lane * 4;
                        if (row < NPR) { const u32x2 w = *(const u32x2*)(Xb + (size_t)row * 1024 + c); v[r2][i] = (f32x4){bflo(w.x), bfhi(w.x), bflo(w.y), bfhi(w.y)}; }
                        else v[r2][i] = *(const f32x4*)(X + (size_t)row * 1024 + c);
                    }
                }
            }
#pragma unroll
            for (int r2 = 0; r2 < 2; ++r2) {
                const int row = row0 + r2 * nb * 8;
                if (row < MR) {
                    float q = 0.f;
#pragma unroll
                    for (int i = 0; i < 4; ++i) q += (v[r2][i][0] * v[r2][i][0] + v[r2][i][1] * v[r2][i][1]) + (v[r2][i][2] * v[r2][i][2] + v[r2][i][3] * v[r2][i][3]);
                    const float rs = 1.0f / sqrtf(wave_sum(q) * (1.0f / 1024.0f) + EPSN);
#pragma unroll
                    for (int i = 0; i < 4; ++i) { const int c = i * 256 + lane * 4; const f32x4 g = *(const f32x4*)(p.in[z + 21] + c); *(f32x4*)(outp_ + (size_t)row * 1024 + c) = v[r2][i] * rs * g; }
                }
            }
        }
        return;
    }
    int l, sub; bool isA;
    if (ph < 15) { isA = true; l = (ph - 1) / 7; sub = (ph - 1) % 7; } else { isA = false; l = 2 + (ph - 15) / 5; sub = (ph - 15) % 5; }
    const int gsub = isA ? sub : (sub == 0 ? 0 : sub == 1 ? 3 : sub + 2);
    const float* ss_mix = ss + (size_t)(2 * l) * NPR * 16; float* ss_mlp = ss + (size_t)(2 * l + 1) * NPR * 16; float* ss_next = ss + (size_t)(2 * l + 2) * NPR * 16;
    if (gsub == 0) {
        if (isA) {
            warm_weights(lds, (const bf16_t*)(ws + WS_WINA) + (size_t)l * 3328 * 1024, 3328 * 1024 * 2);
            EpiProj<0, 0> E; E.O = proj; E.ldc = 3328; E.ss = ss_mix; E.O2 = nullptr; E.outp = nullptr;
            for (int step = 0; step < 2; ++step) {
                if ((step == 0) != (((bid >> 3) & 1) != 0)) {
            skinny_gemm<0, 0, 4, 4>(p, lds, (const bf16_t*)(ws + WS_XSB), 1024, (const bf16_t*)(ws + WS_WINA) + (size_t)l * 3328 * 1024, 3328, 1024, proj, 3328);
                } else {
            run_gemm(lds, Xb, (const bf16_t*)(ws + WS_WINA) + (size_t)l * 3328 * 1024, NPR, 3328, 1024, E);
                }
            }
            if (l == 0) { EpiMemKV M; M.outp = outp_; M.rsm = (const float*)(ws + WS_RSM); M.mkv = (bf16_t*)(ws + WS_MKV); run_gemm(lds, (const bf16_t*)(ws + WS_MEMB), (const bf16_t*)(ws + WS_WMEM), 1024, 2048, 1024, M, 64); }
            if (l == 0) { convert_tiles(p, lds, p.tcut[0], p.tcut[1], 96, 160); copy_swa_cache(p, 0, 96, 160); } else { convert_tiles(p, lds, p.tcut[1], p.tcut[2], 64, 192); copy_swa_cache(p, 1, 64, 192); }
        } else if (l == 2) {
            warm_weights(lds, (const bf16_t*)(ws + WS_WINB0), 1536 * 1024 * 2);
            EpiProj<0, 1> E; E.O = proj; E.ldc = 1024; E.ss = ss_mix; E.O2 = (bf16_t*)(ws + WS_KVS); E.outp = outp_;
            for (int step = 0; step < 2; ++step) {
                if ((step == 0) != (((bid >> 3) & 1) != 0)) {
            skinny_gemm<0, 3, 4, 2>(p, lds, (const bf16_t*)(ws + WS_XSB), 1024, (const bf16_t*)(ws + WS_WINB0), 1536, 1024, proj, 1024);
                } else {
            run_gemm(lds, Xb, (const bf16_t*)(ws + WS_WINB0), NPR, 1536, 1024, E);
                }
            }
            convert_tiles(p, lds, p.tcut[2], p.tcut[3], 128, 128); copy_swa_cache(p, 2, 128, 128);
        } else {
            warm_weights(lds, (const bf16_t*)(ws + WS_WINB1), 1024 * 1024 * 2);
            EpiProj<0, 0> E; E.O = proj; E.ldc = 1024; E.ss = ss_mix; E.O2 = nullptr; E.outp = nullptr;
            for (int step = 0; step < 2; ++step) {
                if ((step == 0) != (((bid >> 3) & 1) != 0)) {
            skinny_gemm<0, 0, 4, 1>(p, lds, (const bf16_t*)(ws + WS_XSB), 1024, (const bf16_t*)(ws + WS_WINB1), 1024, 1024, proj, 1024);
                } else {
            run_gemm(lds, Xb, (const bf16_t*)(ws + WS_WINB1), NPR, 1024, 1024, E);
                }
            }
        }
    } else if (gsub == 1) {
        ret_kvchunk_items(p, lds, bid, 768, nb);
    } else if (gsub == 2) {
        ret_scan(p, l);
    } else if (gsub == 3) {
        const bool dfirst = ((bid >> 3) & 1) != 0;
        for (int step = 0; step < 2; ++step) {
            if ((step == 0) == dfirst) {
                if (isA) {
                    ret_decode_items(p, lds, l, bid, 768, nb);
                    for (int qd = bid; qd < 128; qd += nb) decode_quad<0>(p, lds, l, 0, qd, 512, 3328, 3072);
                } else {
                    for (int qd = bid; qd < 384; qd += nb) decode_quad<1>(p, lds, l, l - 2, qd, 1536, 1024, 768);
                    if (bid >= 128) decode_quad<0>(p, lds, l, l - 2, bid - 128, 512, 1024, 768);
                }
            } else {
                if (isA) {
                    ret_out_items(p, lds, bid, 768, nb);
                    { const AttnArgs Am = mem_attn_args(p, l, bid, 3328, 3072); KVRegs r0, r1; attn_fetch(Am, r0); attn_group<0>(lds, Am, r0, nullptr, r1); }
                } else {
                    {
                        const int sg_ = bid & 3, sb_ = (bid >> 2) & 1, snb_ = bid >> 3;
                        const AttnArgs A1 = swa_args(p, l - 2, sg_ + 4 * snb_ + 128 * sb_, 1024), A2 = swa_args(p, l - 2, sg_ + 4 * snb_ + 128 * (sb_ + 2), 1024), Am = mem_attn_args(p, l, bid, 1024, 768);
                        KVRegs r0, r1; attn_fetch(A1, r0);
                        attn_group<1>(lds, A1, r0, &A2, r1);
                        attn_group<1>(lds, A2, r1, &Am, r0);
                        attn_group<0>(lds, Am, r0, nullptr, r1);
                    }
                }
            }
        }
    } else if (gsub == 4) {
        warm_weights(lds, (const bf16_t*)(ws + WS_WOUT) + (size_t)l * 1024 * 1024, 1024 * 1024 * 2);
        EpiResid E; E.Xb = Xb; E.ss = ss_mlp;
        for (int step = 0; step < 2; ++step) {
            if ((step == 0) != (((bid >> 3) & 1) != 0)) {
        skinny_gemm<1, 2, 4, 1>(p, lds, Ob + (size_t)NPR * 1024, 1024, (const bf16_t*)(ws + WS_WOUT) + (size_t)l * 1024 * 1024, 1024, 1024, nullptr, 0);
            } else {
        run_gemm(lds, Ob, (const bf16_t*)(ws + WS_WOUT) + (size_t)l * 1024 * 1024, NPR, 1024, 1024, E);
            }
        }
    } else if (gsub == 5) {
        warm_weights(lds, (const bf16_t*)(ws + WS_WUP) + (size_t)l * 4096 * 1024, 4096 * 1024 * 2);
        EpiProj<1, 0> E; E.O = proj; E.ldc = 4096; E.ss = ss_mlp; E.O2 = nullptr; E.outp = nullptr;
        for (int step = 0; step < 2; ++step) {
            if ((step == 0) != (((bid >> 3) & 1) != 0)) {
        skinny_gemm<0, 1, 4, 4>(p, lds, (const bf16_t*)(ws + WS_XSB), 1024, (const bf16_t*)(ws + WS_WUP) + (size_t)l * 4096 * 1024, 4096, 1024, proj, 4096);
            } else {
        run_gemm(lds, Xb, (const bf16_t*)(ws + WS_WUP) + (size_t)l * 4096 * 1024, NPR, 4096, 1024, E);
            }
        }
    } else {
        warm_weights(lds, (const bf16_t*)(ws + WS_WDOWN) + (size_t)l * 4096 * 1024, 4096 * 1024 * 2);
        EpiResid E; E.Xb = Xb; E.ss = ss_next;
        for (int step = 0; step < 2; ++step) {
            if ((step == 0) != (((bid >> 3) & 1) != 0)) {
        skinny_gemm<1, 2, 8, 2>(p, lds, proj + (size_t)NPR * 4096, 4096, (const bf16_t*)(ws + WS_WDOWN) + (size_t)l * 4096 * 1024, 1024, 4096, nullptr, 0);
            } else {
        run_gemm(lds, proj, (const bf16_t*)(ws + WS_WDOWN) + (size_t)l * 4096 * 1024, NPR, 1024, 4096, E);
            }
        }
    }
}

__global__ __launch_bounds__(512, 2) void fwd_megakernel(Params p) {
    extern __shared__ __attribute__((aligned(16))) unsigned char shm[];
    LAS unsigned char* lds = (LAS unsigned char*)shm;
    volatile LAS unsigned* st = (volatile LAS unsigned*)(lds + (LDS_BYTES - 16));
    if (threadIdx.x == 0) { st[0] = 0u; st[1] = 0u; }
    __syncthreads();
    const bool multi = (p.ph_hi - p.ph_lo) > 1;
    XcdBarrier xb;
    if (multi) {
        cg::grid_group grid = cg::this_grid();
        xb = xcd_barrier_post((unsigned*)(p.ws + WS_BAR), st);
        grid.sync();
    }
    for (int ph = p.ph_lo; ph < p.ph_hi; ++ph) {
        run_phase(p, lds, ph);
        if (ph + 1 < p.ph_hi) xcd_barrier(xb);
    }
}

extern "C" void kernel_launch(void* const* d_in, const int* in_sizes, int n_in, void* d_out, int out_size, void* d_ws, size_t ws_size, hipStream_t stream) {
    static int grid = 0;
    if (grid == 0) {
        int dev = 0, cus = 0, per_cu = 0;
        hipGetDevice(&dev); hipDeviceGetAttribute(&cus, hipDeviceAttributeMultiprocessorCount, dev);
        if (hipFuncSetAttribute((const void*)fwd_megakernel, hipFuncAttributeMaxDynamicSharedMemorySize, LDS_BYTES) != hipSuccess) { fprintf(stderr, "hipFuncSetAttribute failed\n"); }
        hipOccupancyMaxActiveBlocksPerMultiprocessor(&per_cu, (const void*)fwd_megakernel, 512, LDS_BYTES);
        if (per_cu < 1) per_cu = 1;
        grid = cus * per_cu; (void)hipGetLastError();
        if (ws_size < WS_END) { fprintf(stderr, "workspace too small: %zu < %zu\n", ws_size, (size_t)WS_END); grid = -1; }
    }
    if (grid < 0) return;
    Params p; memset(&p, 0, sizeof(p));
    for (int i = 0; i < 22; ++i) p.in[i] = (const float*)d_in[i];
    p.out = (float*)d_out; p.ws = (unsigned char*)d_ws;
    unsigned char* ws = (unsigned char*)d_ws;
    int nj = 0, ts = 0;
    auto add = [&](const float* src, const float* g, size_t dst_off, int K, int N) {
        Job& j = p.jobs[nj++]; j.src = src; j.g = g; j.dst = (bf16_t*)(ws + dst_off); j.K = K; j.N = N; j.tstart = ts; j.pad = 0; ts += (K / 64) * (N / 64); };
    const float* nmix = p.in[8]; const float* nmem = p.in[14]; const float* nmlp = p.in[18];
    auto up = [&](int l) { add(p.in[19] + (size_t)l * 1024 * 4096, nmlp + l * 1024, WS_WUP + (size_t)l * 4096 * 1024 * 2, 1024, 4096); };
    auto down = [&](int l) { add(p.in[20] + (size_t)l * 4096 * 1024, nullptr, WS_WDOWN + (size_t)l * 4096 * 1024 * 2, 4096, 1024); };
    auto ina = [&](int l) { add(p.in[9] + (size_t)l * 1024 * 3328, nmix + l * 1024, WS_WINA + (size_t)l * 3328 * 1024 * 2, 1024, 3328); };
    auto outa = [&](int l) { add(p.in[10] + (size_t)l * 1024 * 1024, nullptr, WS_WOUT + (size_t)l * 1024 * 1024 * 2, 1024, 1024); };
    auto outb = [&](int j) { add(p.in[12] + (size_t)j * 1024 * 1024, nullptr, WS_WOUT + (size_t)(2 + j) * 1024 * 1024 * 2, 1024, 1024); };
    ina(0); for (int l = 0; l < 4; ++l) add(p.in[15] + (size_t)l * 1024 * 512, nmem + l * 1024, WS_WMEM + (size_t)l * 512 * 1024 * 2, 1024, 512);
    outa(0); up(0); down(0); p.tcut[0] = ts;
    ina(1); outa(1); up(1); down(1); p.tcut[1] = ts;
    add(p.in[11], nmix + 2 * 1024, WS_WINB0, 1024, 1024); add(p.in[17], p.in[16], WS_WINB0 + 1024ull * 1024 * 2, 1024, 512);
    outb(0); up(2); down(2); add(p.in[11] + 1024 * 1024, nmix + 3 * 1024, WS_WINB1, 1024, 1024); outb(1);
    const int s2base = ts; up(3); p.tcut[2] = s2base + 200;
    down(3); p.tcut[3] = ts;
    p.njobs = nj; p.ntiles = ts;
#ifdef MULTI_LAUNCH
    for (int ph = 0; ph < NPHASE; ++ph) { p.ph_lo = ph; p.ph_hi = ph + 1; hipLaunchKernelGGL(fwd_megakernel, dim3(grid), dim3(512), LDS_BYTES, stream, p); }
#else
    p.ph_lo = 0; p.ph_hi = NPHASE;
    (void)hipMemsetAsync(ws + WS_BAR, 0, 16384, stream);
    void* args[] = {&p};
    hipError_t e = hipLaunchCooperativeKernel((const void*)fwd_megakernel, dim3(grid), dim3(512), args, LDS_BYTES, stream);
    if (e != hipSuccess) fprintf(stderr, "cooperative launch failed: %s (grid %d)\n", hipGetErrorString(e), grid);
#endif
}
```
